# Optimizing an MI355X kernel written in HIP

```python
import jax, jax.numpy as jnp
from jax import lax
import numpy as np

D_MODEL = 1024
BATCH = 4
SEQ = 8192
DEPTH = 2

HEAD_DIM = 64
N_Q_HEADS = D_MODEL // HEAD_DIM
N_KV_HEADS = 2
GQA_GROUP = N_Q_HEADS // N_KV_HEADS
WINDOW = 128
ATTN_WIDTH = N_Q_HEADS * HEAD_DIM
KV_WIDTH = N_KV_HEADS * HEAD_DIM
N_BUCKETS = 32
MAX_DISTANCE = 128
SGU_WIDTH = D_MODEL
SGU_GROUPS = 8
SGU_GROUP_DIM = SGU_WIDTH // SGU_GROUPS
CHUNK = 128
N_BRANCHES = 2
EPS = 1e-6
NEG_INF = -1e30
SPLITS = (ATTN_WIDTH, KV_WIDTH, KV_WIDTH, ATTN_WIDTH, SGU_WIDTH, SGU_WIDTH, SGU_WIDTH, D_MODEL, D_MODEL)
IN_COLS = 2 * ATTN_WIDTH + 2 * KV_WIDTH + 3 * SGU_WIDTH + N_BRANCHES * D_MODEL

kernel_name = "hybrid_swa_sink_gmlp_gated_block"


def rms_norm(x, g):
    xf = x.astype(jnp.float32)
    y = xf * lax.rsqrt(jnp.mean(xf * xf, axis=-1, keepdims=True) + EPS)
    return (y * g.astype(jnp.float32)).astype(x.dtype)


def layer_norm(x, g, b):
    xf = x.astype(jnp.float32)
    mu = jnp.mean(xf, axis=-1, keepdims=True)
    xc = xf - mu
    y = xc * lax.rsqrt(jnp.mean(xc * xc, axis=-1, keepdims=True) + EPS)
    return (y * g.astype(jnp.float32) + b.astype(jnp.float32)).astype(x.dtype)


def t5_bucket(dist):
    max_exact = N_BUCKETS // 2
    large = max_exact + (np.log(np.maximum(dist, max_exact) / max_exact)
                         / np.log(MAX_DISTANCE / max_exact)
                         * (N_BUCKETS - max_exact)).astype(np.int32)
    large = np.minimum(large, N_BUCKETS - 1)
    return np.where(dist < max_exact, dist, large).astype(np.int32)


def sliding_window_attention(q, k, v, sinks, rel_bias):
    B, S = q.shape[0], q.shape[1]
    nb = S // WINDOW
    qb = q.reshape(B, nb, WINDOW, N_KV_HEADS, GQA_GROUP, HEAD_DIM)

    def band(t):
        tb = t.reshape(B, nb, WINDOW, N_KV_HEADS, HEAD_DIM)
        prev = jnp.pad(tb, ((0, 0), (1, 0), (0, 0), (0, 0), (0, 0)))[:, :-1]
        return jnp.concatenate([prev, tb], axis=2)

    kb, vb = band(k), band(v)
    scores = jnp.einsum('bnqhgd,bnkhd->bnhgqk', qb, kb,
                        preferred_element_type=jnp.float32) * (HEAD_DIM ** -0.5)

    qi = np.arange(WINDOW)[:, None]
    kj = np.arange(2 * WINDOW)[None, :]
    dist = qi + WINDOW - kj
    in_window = (dist >= 0) & (dist < WINDOW)
    bucket = t5_bucket(np.clip(dist, 0, None))
    bias = jnp.transpose(rel_bias[bucket].astype(jnp.float32), (2, 0, 1))
    bias = bias.reshape(N_KV_HEADS, GQA_GROUP, WINDOW, 2 * WINDOW)
    block_ok = (np.arange(nb)[:, None] > 0) | (np.arange(2 * WINDOW)[None, :] >= WINDOW)
    mask = in_window[None, None, None] & block_ok[:, None, None, None, :]
    scores = jnp.where(mask, scores + bias, NEG_INF)

    sink = sinks.astype(jnp.float32).reshape(N_KV_HEADS, GQA_GROUP, 1, 1)
    m = jnp.maximum(jnp.max(scores, axis=-1, keepdims=True), sink)
    p = jnp.exp(scores - m)
    denom = jnp.sum(p, axis=-1, keepdims=True) + jnp.exp(sink - m)
    probs = (p / denom).astype(vb.dtype)
    out = jnp.einsum('bnhgqk,bnkhd->bnqhgd', probs, vb)
    return out.reshape(B, S, ATTN_WIDTH)


def spatial_gating(u, v, ln_g, ln_b, w_s, b_s):
    B, S = u.shape[0], u.shape[1]
    nc = S // CHUNK
    vn = layer_norm(v, ln_g, ln_b)
    vc = vn.reshape(B, nc, CHUNK, SGU_GROUPS, SGU_GROUP_DIM)
    causal = np.tril(np.ones((CHUNK, CHUNK), dtype=bool))
    w = jnp.where(causal[None], w_s, jnp.zeros_like(w_s))
    mixed = jnp.einsum('gts,bnsgd->bntgd', w, vc) + b_s.T[:, :, None]
    return u * mixed.reshape(B, S, SGU_WIDTH)


def setup_inputs(seed: int = 0) -> dict:
    key = jax.random.key(seed)
    ks = jax.random.split(key, 16)
    f32 = jnp.float32
    nrm = lambda k, shape, s: jax.random.normal(k, shape, f32) * s
    return {
        "x": nrm(ks[0], (BATCH, SEQ, D_MODEL), 1.0),
        "rel_bias": nrm(ks[1], (N_BUCKETS, N_Q_HEADS), 0.5),
        "pre_norm": 1.0 + nrm(ks[2], (DEPTH, D_MODEL), 0.05),
        "post_norm": 1.0 + nrm(ks[3], (DEPTH, D_MODEL), 0.05),
        "w_in": nrm(ks[4], (DEPTH, D_MODEL, IN_COLS), D_MODEL ** -0.5),
        "sinks": nrm(ks[5], (DEPTH, N_Q_HEADS), 0.5),
        "sgu_ln_g": 1.0 + nrm(ks[6], (DEPTH, SGU_WIDTH), 0.05),
        "sgu_ln_b": nrm(ks[7], (DEPTH, SGU_WIDTH), 0.02),
        "w_spatial": nrm(ks[8], (DEPTH, SGU_GROUPS, CHUNK, CHUNK), CHUNK ** -0.5),
        "b_spatial": 1.0 + nrm(ks[9], (DEPTH, SGU_GROUPS, CHUNK), 0.1),
        "w_branch_a": nrm(ks[10], (DEPTH, ATTN_WIDTH, D_MODEL), ATTN_WIDTH ** -0.5),
        "w_branch_b": nrm(ks[11], (DEPTH, SGU_WIDTH, D_MODEL), SGU_WIDTH ** -0.5),
        "w_out": nrm(ks[12], (DEPTH, D_MODEL, D_MODEL), D_MODEL ** -0.5),
    }


def reference(x, rel_bias, pre_norm, post_norm, w_in, sinks, sgu_ln_g, sgu_ln_b,
              w_spatial, b_spatial, w_branch_a, w_branch_b, w_out):
    B, S = x.shape[0], x.shape[1]
    offsets = [int(o) for o in np.cumsum(SPLITS)[:-1]]
    for l in range(DEPTH):
        h = rms_norm(x, pre_norm[l])
        proj = h @ w_in[l]
        q, k, v, gate_a, u_b, v_b, gate_b, mg_a, mg_b = jnp.split(proj, offsets, axis=-1)
        o_a = sliding_window_attention(
            q.reshape(B, S, N_Q_HEADS, HEAD_DIM),
            k.reshape(B, S, N_KV_HEADS, HEAD_DIM),
            v.reshape(B, S, N_KV_HEADS, HEAD_DIM),
            sinks[l], rel_bias)
        y_a = (o_a * jax.nn.silu(gate_a)) @ w_branch_a[l]
        o_b = spatial_gating(jax.nn.gelu(u_b, approximate=False), jax.nn.gelu(v_b, approximate=False),
                             sgu_ln_g[l], sgu_ln_b[l], w_spatial[l], b_spatial[l])
        y_b = (o_b * jax.nn.silu(gate_b)) @ w_branch_b[l]
        merged = jax.nn.sigmoid(mg_a) * y_a + jax.nn.sigmoid(mg_b) * y_b
        out = merged @ w_out[l]
        x = x + rms_norm(out, post_norm[l])
    return x
```

```cpp
#include <hip/hip_runtime.h>
#include <cstdio>
#include <cstdint>

constexpr int BATCH = 4, SEQ = 8192, D = 1024, M = BATCH * SEQ, DEPTH = 2;
constexpr int NH = 16, HD = 64, NKV = 2, WIN = 128;
constexpr int INC = 7424;
constexpr int PP = 6400;
#ifndef PROJ_BLOCKED
#define PROJ_BLOCKED 1
#endif
__host__ __device__ __forceinline__ size_t poff(int row, int col) {
#if PROJ_BLOCKED
    return ((size_t)((row >> 7) * (PP / 64) + (col >> 6)) << 13) + (size_t)(((row & 127) << 6) + (col & 63));
#else
    return (size_t)row * PP + col;
#endif
}
#ifndef HW_BLOCKED
#define HW_BLOCKED 1
#endif
__host__ __device__ __forceinline__ size_t boff(int row, int col, int kb) {
#if HW_BLOCKED
    return ((size_t)((row >> 7) * kb + (col >> 6)) << 13) + (size_t)(((row & 127) << 6) + (col & 63));
#else
    return (size_t)row * (kb * 64) + col;
#endif
}
#if PROJ_BLOCKED
constexpr size_t PO_R128 = (size_t)(PP / 64) << 13, PO_R16 = 16 * 64, PO_C128 = (size_t)2 << 13, PO_C1024 = (size_t)16 << 13;
constexpr int PROW = 64;
#else
constexpr size_t PO_R128 = (size_t)128 * PP, PO_R16 = (size_t)16 * PP, PO_C128 = 128, PO_C1024 = 1024;
constexpr int PROW = PP;
#endif
constexpr int PC_Q = 0, PC_UG = 1024, PC_K = 2048, PC_V = 2176, PC_GA = 2304, PC_VB = 3328, PC_MGA = 4352, PC_MGB = 5376;
constexpr float EPS = 1e-6f;
constexpr float LOG2E = 1.4426950408889634f;
constexpr float C2 = 0.125f * LOG2E;

__device__ __forceinline__ int lane_id_fresh() { unsigned z = 0; asm volatile("" : "+v"(z)); return (int)__builtin_amdgcn_mbcnt_hi(~0u, __builtin_amdgcn_mbcnt_lo(~0u, z)); }

namespace pg8 {
#define PG8_LAS __attribute__((address_space(3)))
typedef unsigned short bf16_t;
typedef short bf16x8 __attribute__((ext_vector_type(8)));
typedef float f32x4 __attribute__((ext_vector_type(4)));
typedef float f32x2 __attribute__((ext_vector_type(2)));
typedef unsigned u32x4 __attribute__((ext_vector_type(4)));
#ifndef WGM1
#define WGM1 4
#endif
constexpr int BM = 256, BK = 64, HALF = 128, HTB = HALF * BK * 2, STAGE_BYTES = 8 * HTB, NXCD = 8;

__host__ __device__ __forceinline__ int lds_byte(int r, int c) { const int st = (r >> 4) * 2 + (c >> 5), rr = r & 15, cc = c & 31, ob = rr * 64 + cc * 2; return st * 1024 + (ob ^ (((ob >> 9) & 1) << 5)); }
__host__ __device__ __forceinline__ void stage_rc(int b, int& R, int& C) { const int st = b / 1024, sb = b % 1024, swz = sb ^ (((sb >> 9) & 1) << 5); R = (st >> 1) * 16 + swz / 64; C = (st & 1) * 32 + (swz % 64) / 2; }
__host__ __device__ __forceinline__ int perm32(int rho) { const int n = rho >> 4, i = rho & 15; return 8 * (i >> 2) + 4 * n + (i & 3); }

struct Unit { int pm, pn; };
struct Gemm { const bf16_t* A; const bf16_t* Bt; int M, N, K, lda, ldb; size_t kstepA, hstepA, kstepB, hstepB; };

template <bool SPLIT_TAIL, int WGM> struct StaticOrderT {
    int nM, nN, nwg, G, c;
    __host__ __device__ void init(int M_, int N_, int G_, int c_) { nM = M_ / BM; nN = N_ / BM; nwg = nM * nN; G = G_; c = c_; }
    __host__ __device__ bool next(int i, Unit& u) const {
        long L = (long)i * G + c; int hb = 0;
        if (SPLIT_TAIL && (nwg - (long)i * G) * 2 == G) { hb = (c >= G / 2) ? 2 : 1; if (hb == 2) L -= G / 2; }
        if (L >= nwg) return false;
        int wgid = (int)L; { const int q = nwg / NXCD, r = nwg % NXCD, xcd = wgid % NXCD, off = wgid / NXCD; wgid = (xcd < r ? xcd * (q + 1) : r * (q + 1) + (xcd - r) * q) + off; }
        const int nig = WGM * nN, gid = wgid / nig, fm = gid * WGM, gsz = (nM - fm) < WGM ? (nM - fm) : WGM;
        u.pm = fm + ((wgid % nig) % gsz); u.pn = ((wgid % nig) / gsz) | (hb << 8); return true;
    }
};
typedef StaticOrderT<false, 4> StaticOrder;
typedef StaticOrderT<true, WGM1> StaticOrderSplit;

__device__ __forceinline__ unsigned cvt_pk_bf16(float lo, float hi) { unsigned r; asm volatile("v_cvt_pk_bf16_f32 %0, %1, %2" : "=v"(r) : "v"(lo), "v"(hi)); return r; }
constexpr float GQ = 255.49f;
__device__ __forceinline__ unsigned pk_u8(float v, unsigned sel, unsigned old) { return __builtin_amdgcn_cvt_pk_u8_f32(v, sel, old); }
__device__ __forceinline__ float bf_lo(unsigned w) { return __builtin_bit_cast(float, w << 16); }
__device__ __forceinline__ float bf_hi(unsigned w) { return __builtin_bit_cast(float, w & 0xffff0000u); }
__device__ __forceinline__ f32x2 gelu_pk(f32x2 v) {
    const f32x2 av = __builtin_elementwise_abs(v), d = av * 0.2316418882f + 1.0f;
    f32x2 t; t.x = __builtin_amdgcn_rcpf(d.x); t.y = __builtin_amdgcn_rcpf(d.y);
    f32x2 q = t * 0.5307027145f + (-0.7265760135f); q = q * t + 0.7107068705f; q = q * t + (-0.142248368f); q = q * t + 0.127414796f; q = q * t;
    const f32x2 s = (v * v) * (-0.72134752044f);
    f32x2 e; e.x = __builtin_amdgcn_exp2f(s.x); e.y = __builtin_amdgcn_exp2f(s.y);
    const f32x2 m = v * (q * e), r = v - m;
    f32x2 o; o.x = v.x < 0.f ? m.x : r.x; o.y = v.y < 0.f ? m.y : r.y; return o;
}
__device__ __forceinline__ float sigmoidf_(float x) { return __builtin_amdgcn_rcpf(1.0f + __builtin_amdgcn_exp2f(-x * LOG2E)); }
__device__ __forceinline__ f32x4 gelu4(f32x4 v) { f32x2 a = gelu_pk((f32x2){v[0], v[1]}), b = gelu_pk((f32x2){v[2], v[3]}); return (f32x4){a.x, a.y, b.x, b.y}; }
__device__ __forceinline__ f32x4 sig4(f32x4 v) { return (f32x4){sigmoidf_(v[0]), sigmoidf_(v[1]), sigmoidf_(v[2]), sigmoidf_(v[3])}; }
__device__ __forceinline__ f32x4 silu4(f32x4 v) { return v * sig4(v); }
__device__ __forceinline__ unsigned cvtpk_n(float lo, float hi) { typedef __bf16 bf2 __attribute__((ext_vector_type(2))); f32x2 v = {lo, hi}; bf2 b = __builtin_convertvector(v, bf2); return __builtin_bit_cast(unsigned, b); }
__device__ __forceinline__ u32x4 pack8(f32x4 v0, f32x4 v1) { u32x4 w; w.x = cvtpk_n(v0[0], v0[1]); w.y = cvtpk_n(v0[2], v0[3]); w.z = cvtpk_n(v1[0], v1[1]); w.w = cvtpk_n(v1[2], v1[3]); return w; }


template <int N> __device__ __forceinline__ void sig_n(float (&v)[N]) {
#pragma unroll
    for (int i = 0; i < N; ++i) v[i] = __builtin_amdgcn_exp2f(v[i] * (-LOG2E));
#pragma unroll
    for (int i = 0; i < N; ++i) v[i] = __builtin_amdgcn_rcpf(v[i] + 1.0f);
}
template <int N> __device__ __forceinline__ void silu_n(float (&v)[N]) {
    float s[N];
#pragma unroll
    for (int i = 0; i < N; ++i) s[i] = v[i];
    sig_n<N>(s);
#pragma unroll
    for (int i = 0; i < N; ++i) v[i] *= s[i];
}
template <int N> __device__ __forceinline__ void gelu_n(float (&v)[N]) {
    float t[N], e[N];
#pragma unroll
    for (int i = 0; i < N; ++i) t[i] = __builtin_amdgcn_rcpf(__builtin_fabsf(v[i]) * 0.2316418882f + 1.0f);
#pragma unroll
    for (int i = 0; i < N; ++i) e[i] = __builtin_amdgcn_exp2f(v[i] * v[i] * (-0.72134752044f));
#pragma unroll
    for (int i = 0; i < N; ++i) { float q = t[i] * 0.5307027145f + (-0.7265760135f); q = q * t[i] + 0.7107068705f; q = q * t[i] + (-0.142248368f); q = q * t[i] + 0.127414796f;
        v[i] = __builtin_fmaf(-__builtin_fabsf(v[i]), q * (t[i] * e[i]), __builtin_fmaxf(v[i], 0.f)); }
}
template <int KIND> __device__ __forceinline__ void epi1_tile(const f32x4 (&acc)[2][2][4][2], bf16_t* base, float* strow, int fq, int half) {
#pragma unroll
    for (int ai = 0; ai < 2; ++ai) { if (half >= 0 && half != ai) continue;
#pragma unroll
        for (int m = 0; m < 4; ++m) { bf16_t* rowp = base + ai * PO_R128 + m * PO_R16;
            float v[16];
#pragma unroll
            for (int bj = 0; bj < 2; ++bj)
#pragma unroll
                for (int n = 0; n < 2; ++n)
#pragma unroll
                    for (int i = 0; i < 4; ++i) v[bj * 8 + n * 4 + i] = acc[ai][bj][m][n][i];
            if (KIND == 6) {
#pragma unroll
                for (int i = 0; i < 16; ++i) v[i] = __builtin_amdgcn_exp2f(v[i] * (-LOG2E));
#pragma unroll
                for (int i = 0; i < 16; ++i) v[i] = __builtin_amdgcn_rcpf(__builtin_fmaf(v[i], 1.0f / GQ, 1.0f / GQ));
                u32x4 w;
                w.x = pk_u8(v[9], 3, pk_u8(v[1], 2, pk_u8(v[8], 1, pk_u8(v[0], 0, 0u)))); w.y = pk_u8(v[11], 3, pk_u8(v[3], 2, pk_u8(v[10], 1, pk_u8(v[2], 0, 0u))));
                w.z = pk_u8(v[13], 3, pk_u8(v[5], 2, pk_u8(v[12], 1, pk_u8(v[4], 0, 0u)))); w.w = pk_u8(v[15], 3, pk_u8(v[7], 2, pk_u8(v[14], 1, pk_u8(v[6], 0, 0u))));
                __builtin_nontemporal_store(w, (u32x4*)rowp);
            } else if (KIND == 1) {
                float u[8], g[8];
#pragma unroll
                for (int i = 0; i < 8; ++i) { u[i] = v[i]; g[i] = v[8 + i]; }
                gelu_n<8>(u); silu_n<8>(g);
                u32x4 w; w.x = cvtpk_n(u[0] * g[0], u[1] * g[1]); w.y = cvtpk_n(u[2] * g[2], u[3] * g[3]); w.z = cvtpk_n(u[4] * g[4], u[5] * g[5]); w.w = cvtpk_n(u[6] * g[6], u[7] * g[7]);
                __builtin_nontemporal_store(w, (u32x4*)rowp);
            } else {
                if (KIND == 0) {
#pragma unroll
                    for (int i = 0; i < 16; ++i) v[i] *= C2; }
                else if (KIND == 3) silu_n<16>(v);
                else if (KIND == 4) { gelu_n<16>(v);
                    float s1 = 0.f, s2 = 0.f;
#pragma unroll
                    for (int i = 0; i < 16; ++i) { s1 += v[i]; s2 += v[i] * v[i]; }
                    s1 += __shfl_xor(s1, 16); s2 += __shfl_xor(s2, 16); s1 += __shfl_xor(s1, 32); s2 += __shfl_xor(s2, 32);
                    if (fq == 0) { float* sp = strow + 2 * (ai * HALF + m * 16); __hip_atomic_fetch_add(sp, s1, __ATOMIC_RELAXED, __HIP_MEMORY_SCOPE_AGENT); __hip_atomic_fetch_add(sp + 1, s2, __ATOMIC_RELAXED, __HIP_MEMORY_SCOPE_AGENT); } }
                else if (KIND == 5) sig_n<16>(v);
#pragma unroll
                for (int bj = 0; bj < 2; ++bj) { u32x4 w; w.x = cvtpk_n(v[bj * 8 + 0], v[bj * 8 + 1]); w.y = cvtpk_n(v[bj * 8 + 2], v[bj * 8 + 3]); w.z = cvtpk_n(v[bj * 8 + 4], v[bj * 8 + 5]); w.w = cvtpk_n(v[bj * 8 + 6], v[bj * 8 + 7]);
                    __builtin_nontemporal_store(w, (u32x4*)(rowp + bj * 32)); }
            }
        }
    }
}
struct Epi1 {
    static constexpr bool PERM = true, HAS_MID = false, HALF_OK = true;
    bf16_t* P; float* stat;
    __device__ __forceinline__ void mid(f32x4 (&)[2][2][4][2], const Unit&, int, int, int, int) const {}
    __device__ __forceinline__ void operator()(f32x4 (&acc)[2][2][4][2], const Unit& u, int wr, int wc, int fr, int fq) const {
        const int pn = u.pn & 255, half = (u.pn >> 8) - 1; int kind, ocol;
        if (pn < 4) { kind = 0; ocol = PC_Q + 256 * pn; } else if (pn < 12) { kind = 1; ocol = PC_UG + 128 * (pn - 4); } else if (pn == 12) { kind = 2; ocol = PC_K; }
        else if (pn < 17) { kind = 3; ocol = PC_GA + 256 * (pn - 13); } else if (pn < 21) { kind = 4; ocol = PC_VB + 256 * (pn - 17); } else { kind = 6; ocol = PC_MGA + 128 * (pn - 21); }
        const bool paired = (kind == 1 || kind == 6);
        bf16_t* base = P + poff(u.pm * BM + wr * 64 + fr, ocol + (paired ? wc * 32 : wc * 64) + 8 * fq);
        float* strow = stat + 2 * (size_t)(u.pm * BM + wr * 64 + fr);
        switch (kind) {
            case 0: epi1_tile<0>(acc, base, strow, fq, half); break;
            case 1: epi1_tile<1>(acc, base, strow, fq, half); break;
            case 2: epi1_tile<2>(acc, base, strow, fq, half); break;
            case 3: epi1_tile<3>(acc, base, strow, fq, half); break;
            case 4: epi1_tile<4>(acc, base, strow, fq, half); break;
            default: epi1_tile<6>(acc, base, strow, fq, half); break;
        }
    }
};
__device__ __forceinline__ float gate_qc() { float z = 0.75f; asm volatile("" : "+v"(z)); return pk_u8(z, 0, 0u) ? 0.0f : 0.5f; }
__device__ __forceinline__ float gate_ratio(unsigned w, float qc) { return __builtin_fmaxf((float)(w & 255u) + qc, 0.25f) * __builtin_amdgcn_rcpf(__builtin_fmaxf((float)((w >> 8) & 255u) + qc, 0.25f)); }
__device__ __forceinline__ float gate_b(unsigned w, float qc) { return __builtin_fmaxf((float)((w >> 8) & 255u) + qc, 0.25f) * (1.0f / GQ); }
struct Epi2 {
    static constexpr bool PERM = true, HAS_MID = true, HALF_OK = false;
    bf16_t* P;
    __device__ __forceinline__ void mid(f32x4 (&acc)[2][2][4][2], const Unit& u, int wr, int wc, int fr, int fq) const {
        int opq = 0; asm volatile("" : "+v"(opq));
        const bf16_t* base = P + poff(u.pm * BM + wr * 64 + fr + opq, PC_MGA + u.pn * BM + wc * 64 + 8 * fq);
        const float qc = gate_qc();
#pragma unroll
        for (int ai = 0; ai < 2; ++ai)
#pragma unroll
            for (int m = 0; m < 4; ++m) { const bf16_t* rowp = base + ai * PO_R128 + m * PO_R16;
#pragma unroll
                for (int bj = 0; bj < 2; ++bj) { const u32x4 a = *(const u32x4*)(rowp + bj * 32);
                    acc[ai][bj][m][0] *= (f32x4){gate_ratio(a.x, qc), gate_ratio(a.x >> 16, qc), gate_ratio(a.y, qc), gate_ratio(a.y >> 16, qc)}; acc[ai][bj][m][1] *= (f32x4){gate_ratio(a.z, qc), gate_ratio(a.z >> 16, qc), gate_ratio(a.w, qc), gate_ratio(a.w >> 16, qc)}; }
                if (m & 1) asm volatile("" ::: "memory"); }
    }
    __device__ __forceinline__ void operator()(f32x4 (&acc)[2][2][4][2], const Unit& u, int wr, int wc, int fr, int fq) const {
        bf16_t* base = P + poff(u.pm * BM + wr * 64 + fr, u.pn * BM + wc * 64 + 8 * fq);
        const float qc = gate_qc();
        constexpr size_t O_MG = (size_t)(PC_MGA / 64) * (PO_C128 / 2), O_GA = (size_t)(PC_GA / 64) * (PO_C128 / 2);
#pragma unroll
        for (int ai = 0; ai < 2; ++ai)
#pragma unroll
            for (int m = 0; m < 4; ++m) { bf16_t* rowp = base + ai * PO_R128 + m * PO_R16;
#pragma unroll
                for (int bj = 0; bj < 2; ++bj) { const u32x4 b = *(const u32x4*)(rowp + O_MG + bj * 32);
                    const f32x4 s0 = (f32x4){gate_b(b.x, qc), gate_b(b.x >> 16, qc), gate_b(b.y, qc), gate_b(b.y >> 16, qc)}, s1 = (f32x4){gate_b(b.z, qc), gate_b(b.z >> 16, qc), gate_b(b.w, qc), gate_b(b.w >> 16, qc)};
                    *(u32x4*)(rowp + O_GA + bj * 32) = pack8(acc[ai][bj][m][0] * s0, acc[ai][bj][m][1] * s1); }
                if (m & 1) asm volatile("" ::: "memory"); }
    }
};
#define PG8_RLX_AGENT __ATOMIC_RELAXED, __HIP_MEMORY_SCOPE_AGENT
struct PanelRms {
    unsigned long long* xbuf;
    unsigned* cnt;
    const float* rs_in;
    float* rsout;
    __device__ __forceinline__ void put(int ai, int m, float s0, float s1, float s2, int wr, int wc, int fr, int fq, PG8_LAS unsigned char* xl) const {
        PG8_LAS float* Pt = (PG8_LAS float*)xl;
        s0 += __shfl_xor(s0, 16); s1 += __shfl_xor(s1, 16); s2 += __shfl_xor(s2, 16); s0 += __shfl_xor(s0, 32); s1 += __shfl_xor(s1, 32); s2 += __shfl_xor(s2, 32);
        if (fq == 0) { PG8_LAS float* p = Pt + ((ai * HALF + wr * 64 + m * 16 + fr) * 3) * 4 + wc; p[0] = s0; p[4] = s1; p[8] = s2; }
    }
    __device__ __forceinline__ void finish(const Unit& u, int wr, int wc, int fr, int fq, PG8_LAS unsigned char* xl) const {
        PG8_LAS float* Pt = (PG8_LAS float*)xl; PG8_LAS f32x2* S = (PG8_LAS f32x2*)(xl + 12288);
        const int wid = wr * 4 + wc, lane = fr + 16 * fq;
        asm volatile("s_waitcnt lgkmcnt(0)" ::: "memory"); __builtin_amdgcn_s_barrier(); asm volatile("" ::: "memory");
        const int row = wid * 32 + (lane & 31);
        if (lane < 32) { float t[3];
#pragma unroll
            for (int k = 0; k < 3; ++k) { const f32x4 a = *(const PG8_LAS f32x4*)(Pt + (row * 3 + k) * 4); t[k] = (a[0] + a[1]) + (a[2] + a[3]); }
            unsigned long long* slot = xbuf + ((size_t)(u.pm * BM + row) * 4 + u.pn) * 2;
            __hip_atomic_store(slot, ((unsigned long long)__builtin_bit_cast(unsigned, t[1]) << 32) | __builtin_bit_cast(unsigned, t[0]), PG8_RLX_AGENT);
            __hip_atomic_store(slot + 1, (unsigned long long)__builtin_bit_cast(unsigned, t[2]), PG8_RLX_AGENT); }
        asm volatile("s_waitcnt vmcnt(0)" ::: "memory");
        if (lane == 0) __hip_atomic_fetch_add(cnt + 64 * u.pm, 1u, PG8_RLX_AGENT);
        if (wid == 0) { unsigned sp = 0;
            while ((unsigned)__builtin_amdgcn_readfirstlane(__hip_atomic_load(cnt + 64 * u.pm, PG8_RLX_AGENT)) < 32u) { __builtin_amdgcn_s_sleep(2); if (++sp > (1u << 22)) break; }
            __builtin_amdgcn_fence(__ATOMIC_ACQUIRE, "agent"); }
        asm volatile("s_waitcnt vmcnt(0) lgkmcnt(0)" ::: "memory"); __builtin_amdgcn_s_barrier(); asm volatile("" ::: "memory");
        if (lane < 32) { const unsigned long long* slot = xbuf + (size_t)(u.pm * BM + row) * 8; float o2 = 0.f, xgo = 0.f, go2 = 0.f;
#pragma unroll
            for (int k = 0; k < 4; ++k) { const unsigned long long w0 = __hip_atomic_load(slot + 2 * k, PG8_RLX_AGENT), w1 = __hip_atomic_load(slot + 2 * k + 1, PG8_RLX_AGENT);
                o2 += __builtin_bit_cast(float, (unsigned)w0); xgo += __builtin_bit_cast(float, (unsigned)(w0 >> 32)); go2 += __builtin_bit_cast(float, (unsigned)w1); }
            const float rs1 = 1.0f / sqrtf(o2 * (1.0f / 1024.0f) + EPS);
            const float ri = rs_in[u.pm * BM + row], sx2 = 1024.0f * (1.0f / (ri * ri) - EPS);
            const float ss2 = fmaxf(sx2 + 2.0f * rs1 * xgo + rs1 * rs1 * go2, 0.f);
            const float rs2 = 1.0f / sqrtf(ss2 * (1.0f / 1024.0f) + EPS);
            S[row] = (f32x2){rs1, rs2}; if (rsout && u.pn == 0) rsout[u.pm * BM + row] = rs2; }
        asm volatile("s_waitcnt lgkmcnt(0)" ::: "memory"); __builtin_amdgcn_s_barrier(); asm volatile("" ::: "memory");
    }
};
struct EpiNorm {
    static constexpr bool PERM = true, HAS_MID = false, HALF_OK = false;
    const bf16_t* hin; const float* rs_in; const float* gin; float* xout; const float* gpost; const float* gpre; bf16_t* hn; PanelRms st; PG8_LAS unsigned char* xl;
    __device__ __forceinline__ void mid(f32x4 (&)[2][2][4][2], const Unit&, int, int, int, int) const {}
    __device__ __forceinline__ void operator()(f32x4 (&acc)[2][2][4][2], const Unit& u, int wr, int wc, int fr, int fq) const {
        int opq = 0; asm volatile("" : "+v"(opq));
        const PG8_LAS f32x2* S = (const PG8_LAS f32x2*)(xl + 12288);
        const int wid = wr * 4 + wc, lane = fr + 16 * fq + opq;
        PG8_LAS float* gt = (PG8_LAS float*)(xl + 14336 + wid * 768);
        { const int gc = u.pn * BM + wc * 64 + lane;
          gt[lane] = gpost[gc]; gt[64 + lane] = __builtin_amdgcn_rcpf(gin[gc]); gt[128 + lane] = hn ? gpre[gc] : 0.f; }
        const int col0a = u.pn * BM + wc * 64 + 8 * fq + opq;
        asm volatile("s_waitcnt lgkmcnt(0)" ::: "memory");
#define EN_ROW(it) (((it) >> 2) * HALF + wr * 64 + ((it) & 3) * 16 + fr)
#define EN_LOAD(it, colx, HV0, HV1, RIN) do { int oq_ = 0; asm volatile("" : "+v"(oq_)); const int r_ = EN_ROW(it) + oq_; const size_t off_ = boff(u.pm * BM + r_, (colx), D / 64); \
            HV0 = *(const u32x4*)(hin + off_); HV1 = *(const u32x4*)(hin + off_ + 32); RIN = rs_in[u.pm * BM + r_]; } while (0)
        u32x4 hc0, hc1, hn0, hn1; float rc, rn;
        EN_LOAD(0, col0a, hn0, hn1, rn);
#pragma unroll
        for (int it = 0; it < 8; ++it) { const int ai = it >> 2, m = it & 3;
            hc0 = hn0; hc1 = hn1; rc = rn;
            if (it < 7) EN_LOAD(it + 1, col0a, hn0, hn1, rn);
            const float rinv = __builtin_amdgcn_rcpf(rc); float s0 = 0.f, s1 = 0.f, s2 = 0.f;
#pragma unroll
            for (int bj = 0; bj < 2; ++bj) { const u32x4 hv = bj ? hc1 : hc0;
                const PG8_LAS float* g = gt + bj * 32 + 8 * fq;
                const f32x4 gp0 = *(const PG8_LAS f32x4*)g, gp1 = *(const PG8_LAS f32x4*)(g + 4), gi0 = *(const PG8_LAS f32x4*)(g + 64), gi1 = *(const PG8_LAS f32x4*)(g + 68);
                const f32x4 x0 = (f32x4){bf_lo(hv.x), bf_hi(hv.x), bf_lo(hv.y), bf_hi(hv.y)} * gi0 * rinv, x1 = (f32x4){bf_lo(hv.z), bf_hi(hv.z), bf_lo(hv.w), bf_hi(hv.w)} * gi1 * rinv;
                const f32x4 a0 = acc[ai][bj][m][0], a1 = acc[ai][bj][m][1], g0 = a0 * gp0, g1 = a1 * gp1;
#pragma unroll
                for (int i = 0; i < 4; ++i) { s0 += a0[i] * a0[i] + a1[i] * a1[i]; s1 += x0[i] * g0[i] + x1[i] * g1[i]; s2 += g0[i] * g0[i] + g1[i] * g1[i]; } }
            st.put(ai, m, s0, s1, s2, wr, wc, fr, fq, xl); }
        int opq2 = 0; asm volatile("" : "+v"(opq2));
        const int col0 = col0a + opq2;
        EN_LOAD(0, col0, hn0, hn1, rn);
        st.finish(u, wr, wc, fr, fq, xl);
#pragma unroll
        for (int it = 0; it < 8; ++it) { const int ai = it >> 2, m = it & 3;
            hc0 = hn0; hc1 = hn1; rc = rn;
            if (it < 7) EN_LOAD(it + 1, col0, hn0, hn1, rn);
            int oq = 0; asm volatile("" : "+v"(oq));
            const int r = EN_ROW(it) + oq; const f32x2 rs = S[r]; const size_t off = (size_t)(u.pm * BM + r) * D + col0, offh = boff(u.pm * BM + r, col0, D / 64);
            const float rinv = __builtin_amdgcn_rcpf(rc);
#pragma unroll
            for (int bj = 0; bj < 2; ++bj) { const u32x4 hv = bj ? hc1 : hc0;
                const PG8_LAS float* g = gt + bj * 32 + 8 * fq;
                const f32x4 gp0 = *(const PG8_LAS f32x4*)g, gp1 = *(const PG8_LAS f32x4*)(g + 4), gi0 = *(const PG8_LAS f32x4*)(g + 64), gi1 = *(const PG8_LAS f32x4*)(g + 68);
                const f32x4 x0 = (f32x4){bf_lo(hv.x), bf_hi(hv.x), bf_lo(hv.y), bf_hi(hv.y)} * gi0 * rinv, x1 = (f32x4){bf_lo(hv.z), bf_hi(hv.z), bf_lo(hv.w), bf_hi(hv.w)} * gi1 * rinv;
                const f32x4 o0 = x0 + acc[ai][bj][m][0] * rs.x * gp0, o1 = x1 + acc[ai][bj][m][1] * rs.x * gp1;
                if (xout) { *(f32x4*)(xout + off + bj * 32) = o0; *(f32x4*)(xout + off + bj * 32 + 4) = o1; }
                if (hn) { const f32x4 gq0 = *(const PG8_LAS f32x4*)(g + 128), gq1 = *(const PG8_LAS f32x4*)(g + 132); *(u32x4*)(hn + offh + bj * 32) = pack8(o0 * rs.y * gq0, o1 * rs.y * gq1); } } }
#undef EN_ROW
#undef EN_LOAD
    }
};

template <class Epi, class Sched, bool ALIGN_EPI = false>
__device__ __forceinline__ void gemm_phase(PG8_LAS unsigned char* lds, const Gemm g, const Sched& S, const Epi& E, int wave_) {
    int wid_ = wave_; asm volatile("" : "+s"(wid_));
    const int wid = wid_, lane = lane_id_fresh(), tid = wid * 64 + lane,
              wr = wid >> 2, wc = wid & 3, fr = lane & 15, fq = lane >> 4;
    const int K = g.K, nt = K / BK;
    unsigned voffA[2], voffB[2];
#pragma unroll
    for (int i = 0; i < 2; ++i) { int R, C; stage_rc(tid * 16 + i * 8192, R, C); const int Rb = Epi::PERM ? ((R & ~31) + perm32(R & 31)) : R;
        voffA[i] = (unsigned)(R * g.lda + C) * 2u; voffB[i] = (unsigned)(Rb * g.ldb + C) * 2u; }
    const size_t kstep = g.kstepB, kstepA = g.kstepA;
    const size_t hstepA = g.hstepA, hstepB = g.hstepB;
    const size_t tstepA = 2 * hstepA, tstepB = 2 * hstepB;
    const unsigned ldsw = (unsigned)wid * 1024u;
    const int aoff = lds_byte(wr * 64 + fr, fq * 8), boff = lds_byte(wc * 32 + fr, fq * 8);
#define PG8_SA(b, h) (((b) * 2 + (h)) * HTB)
#define PG8_SB(b, h) ((4 + (b) * 2 + (h)) * HTB)
#define PG8_STAGE(bufoff, gbase, voff) do { _Pragma("unroll") for (int _i = 0; _i < 2; ++_i) \
        __builtin_amdgcn_global_load_lds((const unsigned*)((const char*)(gbase) + (voff)[_i]), (PG8_LAS unsigned*)(lds + (bufoff) + ldsw + _i * 8192), 16, 0, 0); } while (0)
#define PG8_LDA(dst, b, h) do { _Pragma("unroll") for (int m = 0; m < 4; ++m) _Pragma("unroll") for (int k = 0; k < 2; ++k) dst[m][k] = *(const PG8_LAS bf16x8*)(lds + PG8_SA(b, h) + aoff + m * 2048 + k * 1024); } while (0)
#define PG8_LDB(dst, b, h) do { _Pragma("unroll") for (int n = 0; n < 2; ++n) _Pragma("unroll") for (int k = 0; k < 2; ++k) dst[n][k] = *(const PG8_LAS bf16x8*)(lds + PG8_SB(b, h) + boff + n * 2048 + k * 1024); } while (0)
#define PG8_MMA(ai, bj, At, Bt) do { __builtin_amdgcn_s_setprio(1); _Pragma("unroll") for (int m = 0; m < 4; ++m) _Pragma("unroll") for (int n = 0; n < 2; ++n) _Pragma("unroll") for (int k = 0; k < 2; ++k) \
        acc[ai][bj][m][n] = __builtin_amdgcn_mfma_f32_16x16x32_bf16(Bt[n][k], At[m][k], acc[ai][bj][m][n], 0, 0, 0); __builtin_amdgcn_s_setprio(0); } while (0)
#define PG8_WAIT_V(n) asm volatile("s_waitcnt vmcnt(" #n ")" ::: "memory")
#define PG8_WAIT_L(n) asm volatile("s_waitcnt lgkmcnt(" #n ")" ::: "memory")
#define PG8_BAR __builtin_amdgcn_s_barrier()
#define PG8_SCHED __builtin_amdgcn_sched_barrier(0)
    Unit cur, nxt; int ui = 0;
    if (!S.next(0, cur)) return;
    f32x4 acc[2][2][4][2];
#pragma unroll
    for (int a = 0; a < 2; ++a)
#pragma unroll
        for (int b = 0; b < 2; ++b)
#pragma unroll
            for (int m = 0; m < 4; ++m)
#pragma unroll
                for (int n = 0; n < 2; ++n) acc[a][b][m][n] = (f32x4){0.f, 0.f, 0.f, 0.f};
    bf16x8 At[4][2], B0[2][2], B1[2][2];
    const char* cA = (const char*)g.A + (size_t)cur.pm * tstepA; const char* cB = (const char*)g.Bt + (size_t)(cur.pn & 255) * tstepB;
    PG8_STAGE(PG8_SB(0, 0), cB, voffB); PG8_STAGE(PG8_SB(0, 1), cB + hstepB, voffB); PG8_STAGE(PG8_SA(0, 0), cA, voffA); PG8_STAGE(PG8_SA(0, 1), cA + hstepA, voffA);
    if (wr == 1) PG8_BAR;
    PG8_WAIT_V(2); PG8_BAR;
    PG8_STAGE(PG8_SB(1, 0), cB + kstep, voffB); PG8_STAGE(PG8_SA(1, 0), cA + kstepA, voffA); PG8_STAGE(PG8_SB(1, 1), cB + hstepB + kstep, voffB);
    PG8_WAIT_V(6); PG8_BAR;
    for (;;) {
        const bool has_next = S.next(ui + 1, nxt);
        const char* nA = has_next ? (const char*)g.A + (size_t)nxt.pm * tstepA : cA; const char* nB = has_next ? (const char*)g.Bt + (size_t)(nxt.pn & 255) * tstepB : cB;
        for (int t = 0; t < nt; t += 2) {
            if constexpr (Epi::HAS_MID) { if (t == (nt >> 1)) E.mid(acc, cur, wr, wc, fr, fq); }
            const bool last = (t == nt - 2);
            const char* a1 = cA + (size_t)(t + 1) * kstepA;
            const char* a2 = last ? nA : cA + (size_t)(t + 2) * kstepA; const char* b2 = last ? nB : cB + (size_t)(t + 2) * kstep;
            const char* a3 = a2 + kstepA; const char* b3 = b2 + kstep;
            PG8_LDB(B0, 0, 0); PG8_LDB(B1, 0, 1); PG8_SCHED; PG8_LDA(At, 0, 0); PG8_STAGE(PG8_SA(1, 1), a1 + hstepA, voffA);
            PG8_WAIT_V(8); PG8_WAIT_L(0); PG8_BAR; if (!Epi::HALF_OK || (cur.pn >> 8) != 2) { PG8_MMA(0, 0, At, B0); PG8_MMA(0, 1, At, B1); } PG8_BAR; PG8_SCHED;
            PG8_LDA(At, 0, 1); PG8_STAGE(PG8_SB(0, 0), b2, voffB); PG8_STAGE(PG8_SB(0, 1), b2 + hstepB, voffB); PG8_STAGE(PG8_SA(0, 0), a2, voffA);
            PG8_WAIT_V(8); PG8_WAIT_L(0); PG8_BAR; if (!Epi::HALF_OK || (cur.pn >> 8) != 1) { PG8_MMA(1, 0, At, B0); PG8_MMA(1, 1, At, B1); } PG8_BAR; PG8_SCHED;
            PG8_LDB(B0, 1, 0); PG8_LDB(B1, 1, 1); PG8_SCHED; PG8_LDA(At, 1, 0); PG8_STAGE(PG8_SA(0, 1), a2 + hstepA, voffA);
            PG8_WAIT_V(8); PG8_WAIT_L(0); PG8_BAR; if (!Epi::HALF_OK || (cur.pn >> 8) != 2) { PG8_MMA(0, 0, At, B0); PG8_MMA(0, 1, At, B1); } PG8_BAR; PG8_SCHED;
            PG8_LDA(At, 1, 1); PG8_STAGE(PG8_SB(1, 0), b3, voffB); PG8_STAGE(PG8_SB(1, 1), b3 + hstepB, voffB); PG8_STAGE(PG8_SA(1, 0), a3, voffA);
            PG8_WAIT_V(8); PG8_WAIT_L(0); PG8_BAR; if (!Epi::HALF_OK || (cur.pn >> 8) != 1) { PG8_MMA(1, 0, At, B0); PG8_MMA(1, 1, At, B1); } PG8_BAR; PG8_SCHED;
        }
        if constexpr (ALIGN_EPI) { if (wr == 0) PG8_BAR; }
        E(acc, cur, wr, wc, fr, fq);
        if (!has_next) break;
#pragma unroll
        for (int a = 0; a < 2; ++a)
#pragma unroll
            for (int b = 0; b < 2; ++b)
#pragma unroll
                for (int m = 0; m < 4; ++m)
#pragma unroll
                    for (int n = 0; n < 2; ++n) acc[a][b][m][n] = (f32x4){0.f, 0.f, 0.f, 0.f};
        cur = nxt; cA = nA; cB = nB; ++ui;
        if constexpr (ALIGN_EPI) { if (wr == 1) PG8_BAR; }
    }
    PG8_WAIT_V(0);
    if constexpr (!ALIGN_EPI) { if (wr == 0) PG8_BAR; }
    PG8_BAR;
#undef PG8_SA
#undef PG8_SB
#undef PG8_STAGE
#undef PG8_LDA
#undef PG8_LDB
#undef PG8_MMA
#undef PG8_WAIT_V
#undef PG8_WAIT_L
#undef PG8_BAR
#undef PG8_SCHED
}
}

constexpr size_t MiB = 1u << 20;
constexpr size_t WS_CTL = 0, CTL_ZERO_BYTES = 192 * 1024;
constexpr size_t WS_TY = 192 * 1024;
constexpr size_t WS_WT = 256 * 1024;
constexpr size_t WS_BT1 = 1 * MiB;
constexpr size_t BT1_L = (size_t)INC * D * 2;
constexpr size_t WS_BT2 = 30 * MiB;
constexpr size_t BT2_L = (size_t)D * 2 * D * 2;
constexpr size_t WS_BT3 = 38 * MiB;
constexpr size_t BT3_L = (size_t)D * D * 2;
constexpr size_t WS_H = 42 * MiB;
constexpr size_t WS_P = 106 * MiB;
constexpr size_t WS_RS = 510 * MiB;
constexpr size_t WS_ST = 511 * MiB, ST_BYTES = (size_t)DEPTH * M * 2 * 4;
constexpr size_t WS_END = 511 * MiB + 512 * 1024;
static_assert(WS_BT1 + 2 * BT1_L <= WS_BT2 && WS_BT2 + 2 * BT2_L <= WS_BT3 && WS_BT3 + 2 * BT3_L <= WS_H && WS_H + (size_t)M * D * 2 <= WS_P && WS_P + (size_t)M * PP * 2 <= WS_END, "ws map");
constexpr int CW_BAR = 1024;
constexpr int CW_SEAM = 8192, SEAM_BANK = 128 * 64;
constexpr size_t WS_XS = 506 * MiB, XS_BYTES = (size_t)M * 4 * 16;
static_assert((CW_SEAM + 4 * SEAM_BANK) * 4 <= (int)CTL_ZERO_BYTES && CTL_ZERO_BYTES <= 256 * 1024, "ctl words");

constexpr int RING_OFF = 0, RING_BYTES = 131072;
constexpr int LDSCTL_OFF = RING_BYTES, MISC_OFF = LDSCTL_OFF + 320;
constexpr int XTRA_OFF = RING_BYTES + 1024;
constexpr int LDS_BYTES = 163840;

constexpr int NWAVES = 8;
constexpr int GRID = 256;
#define GAS __attribute__((address_space(1)))
#define LAS __attribute__((address_space(3)))
typedef unsigned short bf16;
typedef unsigned v4u __attribute__((ext_vector_type(4)));
typedef float f32x4 __attribute__((ext_vector_type(4)));
#define LDS_WAIT() asm volatile("s_waitcnt lgkmcnt(0)" ::: "memory")
#define VM_WAIT() asm volatile("s_waitcnt vmcnt(0)" ::: "memory")
__device__ __forceinline__ unsigned f2bf(float f) { unsigned u = __builtin_bit_cast(unsigned, f); return (u + 0x7fffu + ((u >> 16) & 1u)) >> 16; }
__device__ __forceinline__ unsigned pk2(float lo, float hi) { return f2bf(lo) | (f2bf(hi) << 16); }
__device__ __forceinline__ float bflo(unsigned w) { return __builtin_bit_cast(float, w << 16); }
__device__ __forceinline__ float bfhi(unsigned w) { return __builtin_bit_cast(float, w & 0xffff0000u); }
__device__ __forceinline__ float bf1(bf16 b) { return __builtin_bit_cast(float, (unsigned)b << 16); }

#define XB_TMO      128
#define XB_XCNT(j)  (256  + 64 * (j))
#define XB_XSUB(j)  (1280 + 64 * (j))
#define XB_XGEN(j)  (2304 + 64 * (j))
#define XB_TOP      3328
#define XB_TOPGEN   3392
#define XCD_BAR_WORDS 3456
#define XB_SPIN_CAP (1u << 18)
__device__ __forceinline__ unsigned xb_ld(unsigned* p)              { return __hip_atomic_load(p, __ATOMIC_RELAXED, __HIP_MEMORY_SCOPE_AGENT); }
__device__ __forceinline__ unsigned xb_add(unsigned* p, unsigned v) { return __hip_atomic_fetch_add(p, v, __ATOMIC_RELAXED, __HIP_MEMORY_SCOPE_AGENT); }
__device__ __forceinline__ unsigned xb_xcc_id() { return (unsigned)__builtin_amdgcn_s_getreg((3 << 11) | 20) & 0xFu; }
#define XB_SPIN(cond, bar) do { unsigned _sp = 0; while (cond) { __builtin_amdgcn_s_sleep(1); \
    if ((++_sp & 255u) == 0u) { if (xb_ld(&(bar)[XB_TMO])) break; if (_sp > XB_SPIN_CAP) { atomicAdd(&(bar)[XB_TMO], 1u); break; } } } } while (0)
struct XcdBarrier { unsigned* bar; unsigned x; volatile LAS unsigned* st; };
__device__ __forceinline__ XcdBarrier xcd_barrier_post(unsigned* bar, volatile LAS unsigned* st) {
    XcdBarrier b; b.bar = bar; b.x = xb_xcc_id(); b.st = st;
    if (threadIdx.x == 0) (void)xb_add(&bar[XB_XCNT(b.x)], 1u);
    return b;
}
__device__ __forceinline__ void xcd_barrier_complete(unsigned* bar, unsigned x, unsigned& nloc, unsigned& nx) {
    const unsigned G = gridDim.x * gridDim.y * gridDim.z;
    unsigned sum, cnt, mine, sp = 0u;
    for (;;) {
        sum = 0u; cnt = 0u; mine = 0u;
#pragma unroll
        for (unsigned j = 0; j < 16; ++j) { const unsigned c = xb_ld(&bar[XB_XCNT(j)]); sum += c; cnt += (c > 0u) ? 1u : 0u; mine = (j == x) ? c : mine; }
        if (sum == G) break;
        __builtin_amdgcn_s_sleep(1);
        if ((++sp & 255u) == 0u) { if (xb_ld(&bar[XB_TMO])) break; if (sp > XB_SPIN_CAP) { atomicAdd(&bar[XB_TMO], 1u); break; } }
    }
    nloc = mine > 0u ? mine : 1u; nx = cnt > 0u ? cnt : 1u;
}
__device__ __forceinline__ void xcd_barrier(const XcdBarrier& b, int wave) {
    asm volatile("s_waitcnt vmcnt(0)" ::: "memory");
    __syncthreads();
    if (wave == 0 && lane_id_fresh() == 0) {
        unsigned* bar = b.bar;
        __builtin_amdgcn_s_waitcnt(0);
        unsigned nloc = b.st[0], nx = b.st[1];
        if (nloc == 0u) { xcd_barrier_complete(bar, b.x, nloc, nx); b.st[0] = nloc; b.st[1] = nx; }
        const unsigned old = xb_add(&bar[XB_XSUB(b.x)], 1u);
        const unsigned gen = old / nloc;
        if (old + 1u == (gen + 1u) * nloc) {
            __builtin_amdgcn_fence(__ATOMIC_RELEASE, "agent");
            asm volatile("s_waitcnt vmcnt(0)" ::: "memory");
            const unsigned og = xb_add(&bar[XB_TOP], 1u);
            const unsigned tg = og / nx;
            if (og + 1u == (tg + 1u) * nx) xb_add(&bar[XB_TOPGEN], 1u);
            else XB_SPIN(xb_ld(&bar[XB_TOPGEN]) == tg, bar);
            __builtin_amdgcn_fence(__ATOMIC_ACQUIRE, "agent");
            xb_add(&bar[XB_XGEN(b.x)], 1u);
            asm volatile("s_waitcnt vmcnt(0)" ::: "memory");
        } else {
            XB_SPIN(xb_ld(&bar[XB_XGEN(b.x)]) == gen, bar);
            __builtin_amdgcn_fence(__ATOMIC_ACQUIRE, "agent");
            asm volatile("s_waitcnt vmcnt(0)" ::: "memory");
        }
    }
    __syncthreads();
}

struct Args {
    const float *x, *rel_bias, *pre_norm, *post_norm, *w_in, *sinks, *ln_g, *ln_b, *w_sp, *b_sp, *w_a, *w_b, *w_out;
    float* out; unsigned char* ws; int ph_lo, ph_hi;
};
struct Frame { LAS unsigned char* lds; int tid, lane, wave, vcu, G; };

__device__ __forceinline__ Frame reframe(const Frame& F0) { Frame F = F0; asm volatile("" : "+s"(F.wave), "+s"(F.vcu)); F.lane = lane_id_fresh(); F.tid = F.wave * 64 + F.lane; return F; }
__device__ __forceinline__ float wave_sum(float v) {
#pragma unroll
    for (int o = 1; o < 64; o <<= 1) v += __shfl_xor(v, o);
    return v;
}
__device__ __forceinline__ void transpose_item(const float* W, int ldw, int k0, int n0, bf16* WT, int ldt, int drow0, int dk0, LAS float* scr, int lane) {
    float wv[32];
#pragma unroll
    for (int i = 0; i < 32; ++i) { const int kk = 2 * i + (lane >> 5); wv[i] = W[(size_t)(k0 + kk) * ldw + n0 + (lane & 31)]; }
#pragma unroll
    for (int i = 0; i < 32; ++i) { const int kk = 2 * i + (lane >> 5); scr[kk * 33 + (lane & 31)] = wv[i]; }
    LDS_WAIT(); asm volatile("" ::: "memory");
    const int c = lane & 7;
#pragma unroll
    for (int j = 0; j < 4; ++j) { const int n = (lane >> 3) + 8 * j; const LAS float* s = scr + (8 * c) * 33 + n;
        v4u o; o.x = pk2(s[0 * 33], s[1 * 33]); o.y = pk2(s[2 * 33], s[3 * 33]); o.z = pk2(s[4 * 33], s[5 * 33]); o.w = pk2(s[6 * 33], s[7 * 33]);
        *(GAS v4u*)(WT + boff(drow0 + n, dk0 + k0 + 8 * c, ldt / 64)) = o; }
    LDS_WAIT(); asm volatile("" ::: "memory");
}
__host__ __device__ __forceinline__ int tile_perm(int cc) { return 128 * ((cc >> 5) & 1) + 32 * (cc >> 6) + (cc & 31); }
__device__ __forceinline__ int bt1_row(int n) {
    int r;
    if (n < 1024) r = n;
    else if (n < 1152) r = 3072 + (n - 1024);
    else if (n < 1280) r = 3200 + (n - 1152);
    else if (n < 2304) r = 3328 + (n - 1280);
    else if (n < 3328) { const int c = n - 2304; return 1024 + 256 * (c >> 7) + (c & 127); }
    else if (n < 4352) r = 4352 + (n - 3328);
    else if (n < 5376) { const int c = n - 4352; return 1024 + 256 * (c >> 7) + 128 + (c & 127); }
    else if (n < 6400) { const int c = n - 5376; return 5376 + 256 * (c >> 7) + (c & 127); }
    else { const int c = n - 6400; return 5376 + 256 * (c >> 7) + 128 + (c & 127); }
    return (r & ~255) + tile_perm(r & 255);
}
__device__ __forceinline__ void rms_row_to_bf16(const f32x4 (&v)[4], const float* g, bf16* Hb, int row, int lane, float* rs_out = nullptr) {
    float s2 = 0.f;
#pragma unroll
    for (int j = 0; j < 4; ++j) s2 += (v[j].x * v[j].x + v[j].y * v[j].y) + (v[j].z * v[j].z + v[j].w * v[j].w);
    const float rstd = 1.0f / sqrtf(wave_sum(s2) * (1.f / D) + EPS);
    if (rs_out && lane == 0) *rs_out = rstd;
#pragma unroll
    for (int j = 0; j < 4; ++j) { const f32x4 gg = *(const f32x4*)(g + 256 * j + 4 * lane);
        *(GAS unsigned long long*)(Hb + boff(row, 256 * j + 4 * lane, D / 64)) = (unsigned long long)pk2(v[j].x * rstd * gg.x, v[j].y * rstd * gg.y) | ((unsigned long long)pk2(v[j].z * rstd * gg.z, v[j].w * rstd * gg.w) << 32); }
}

__device__ __forceinline__ int t5_bucket(int d) {
    if (d < 16) return d;
    int b = 16;
    b += (d >= 19); b += (d >= 21); b += (d >= 24); b += (d >= 27); b += (d >= 31); b += (d >= 35); b += (d >= 40); b += (d >= 46);
    b += (d >= 52); b += (d >= 59); b += (d >= 67); b += (d >= 77); b += (d >= 87); b += (d >= 99); b += (d >= 113);
    return b;
}

__device__ __forceinline__ void p0_prologue(const Frame& F0, const Args& a) {
    const Frame F = reframe(F0);
    LAS float* scr = (LAS float*)(F.lds + RING_OFF + F.wave * 16384);
    const int gw = F.vcu * NWAVES + F.wave, NGW = F.G * NWAVES;
    constexpr int I_IN = (D / 64) * (INC / 32), I_SQ = (D / 64) * (D / 32);
    constexpr int PER_L = I_IN + 3 * I_SQ, NITEMS = DEPTH * PER_L;
    bf16* ws16 = (bf16*)a.ws;
    for (int it = gw; it < NITEMS; it += NGW) {
        const int l = it / PER_L; int r = it % PER_L;
        if (r < I_IN) { const int nblk = INC / 32, kb = r / nblk, nb = r % nblk;
            transpose_item(a.w_in + (size_t)l * D * INC, INC, 64 * kb, 32 * nb, (bf16*)(a.ws + WS_BT1 + l * BT1_L), D, bt1_row(32 * nb), 0, scr, F.lane); continue; }
        r -= I_IN;
        const int which = r / I_SQ; r %= I_SQ; const int kb = r / (D / 32), nb = r % (D / 32);
        if (which == 0) transpose_item(a.w_a + (size_t)l * D * D, D, 64 * kb, 32 * nb, (bf16*)(a.ws + WS_BT2 + l * BT2_L), 2 * D, ((32 * nb) & ~255) + tile_perm((32 * nb) & 255), 0, scr, F.lane);
        else if (which == 1) transpose_item(a.w_b + (size_t)l * D * D, D, 64 * kb, 32 * nb, (bf16*)(a.ws + WS_BT2 + l * BT2_L), 2 * D, ((32 * nb) & ~255) + tile_perm((32 * nb) & 255), D, scr, F.lane);
        else transpose_item(a.w_out + (size_t)l * D * D, D, 64 * kb, 32 * nb, (bf16*)(a.ws + WS_BT3 + l * BT3_L), D, ((32 * nb) & ~255) + tile_perm((32 * nb) & 255), 0, scr, F.lane);
    }
    (void)ws16;
    { const int gt = F.vcu * NWAVES * 64 + F.wave * 64 + F.lane;
        if (gt < 16 * 2 * 192) { const int h = gt / 384, rem = gt % 384, sp = rem / 192, j = rem % 192, dist = 159 - (j + sp);
            const float v = (dist >= 0 && dist < 128) ? a.rel_bias[t5_bucket(dist) * NH + h] * LOG2E : -1e30f;
            *(float*)(a.ws + WS_TY + h * 1792 + sp * 896 + j * 4) = v; } }
    { bf16* Wt = (bf16*)(a.ws + WS_WT);
        const int gt = F.vcu * NWAVES * 64 + F.wave * 64 + F.lane, NT = F.G * NWAVES * 64;
        for (int it = gt; it < DEPTH * 8 * 128 * 16; it += NT) { const int s8 = (it & 15) * 8, tt = (it >> 4) & 127; const float* src = a.w_sp + (size_t)(it >> 4) * 128 + s8;
            const f32x4 w0 = *(const f32x4*)src, w1 = *(const f32x4*)(src + 4); v4u o;
            o.x = pk2(s8 + 0 <= tt ? w0.x : 0.f, s8 + 1 <= tt ? w0.y : 0.f); o.y = pk2(s8 + 2 <= tt ? w0.z : 0.f, s8 + 3 <= tt ? w0.w : 0.f);
            o.z = pk2(s8 + 4 <= tt ? w1.x : 0.f, s8 + 5 <= tt ? w1.y : 0.f); o.w = pk2(s8 + 6 <= tt ? w1.z : 0.f, s8 + 7 <= tt ? w1.w : 0.f);
            *(v4u*)(Wt + (size_t)(it >> 4) * 128 + s8) = o; } }
    bf16* H = (bf16*)(a.ws + WS_H);
    for (int m = gw * 4; m < M; m += NGW * 4) {
        f32x4 v[4][4];
#pragma unroll
        for (int r = 0; r < 4; ++r) { const GAS f32x4* xr = (const GAS f32x4*)(a.x + (size_t)(m + r) * D) + F.lane;
#pragma unroll
            for (int j = 0; j < 4; ++j) v[r][j] = xr[64 * j]; }
#pragma unroll
        for (int r = 0; r < 4; ++r) rms_row_to_bf16(v[r], a.pre_norm, H, m + r, F.lane, (float*)(a.ws + WS_RS) + m + r);
    }
}

namespace mix {
typedef short bf16x8 __attribute__((ext_vector_type(8)));
typedef short s16x4 __attribute__((ext_vector_type(4)));
typedef float f32x16 __attribute__((ext_vector_type(16)));
typedef float f32x2 __attribute__((ext_vector_type(2)));
constexpr float NEG = -1e30f;
constexpr int L_K = 0, L_V = 32768, L_OST = 65536, L_BIAS = RING_BYTES + 1024, L_STAT = L_BIAS + 28672;
static_assert(L_STAT + 1024 <= LDS_BYTES, "mixer LDS map");
constexpr int BIAS_H = 1792, BIAS_S = 896;
__device__ __forceinline__ int crow(int r, int hi) { return (r & 3) + 8 * (r >> 2) + 4 * hi; }
__device__ __forceinline__ unsigned cvtpk(float lo, float hi) { typedef __bf16 bf2 __attribute__((ext_vector_type(2))); f32x2 v = {lo, hi}; bf2 b = __builtin_convertvector(v, bf2); return __builtin_bit_cast(unsigned, b); }
__device__ __forceinline__ s16x4 vtr(const LAS unsigned char* p) { typedef short v4i16_t __attribute__((ext_vector_type(4))); return __builtin_bit_cast(s16x4, __builtin_amdgcn_ds_read_tr16_b64_v4i16((LAS v4i16_t*)p)); }
__device__ __forceinline__ float xhalf_max(float m) { auto rr = __builtin_amdgcn_permlane32_swap(__float_as_uint(m), __float_as_uint(m), false, false); return fmaxf(__uint_as_float(rr[0]), __uint_as_float(rr[1])); }
__device__ __forceinline__ float xhalf_sum(float m) { auto rr = __builtin_amdgcn_permlane32_swap(__float_as_uint(m), __float_as_uint(m), false, false); return __uint_as_float(rr[0]) + __uint_as_float(rr[1]); }

__device__ __forceinline__ void attn_item(LAS unsigned char* lds, bf16* Qc, const bf16* Gc, bool first, int h, int qi, float sink2, int lane_, int wave, bf16x8 (&qf)[4], bool pre) {
    int lane = lane_; asm volatile("" : "+v"(lane));
    const int q = lane & 31, hi = lane >> 5;
    bf16x8 qn[4];
    if (pre) { const bf16* qrow = Qc + (32 * (qi + 1) + q) * PROW + 8 * hi;
#pragma unroll
        for (int d0 = 0; d0 < 4; ++d0) qn[d0] = *(const bf16x8*)(qrow + 16 * d0); }
    else {
#pragma unroll
        for (int d0 = 0; d0 < 4; ++d0) qn[d0] = qf[d0]; }
    v4u gl[4];
#pragma unroll
    for (int i = 0; i < 4; ++i) gl[i] = *(const v4u*)(Gc + (32 * qi + i * 8 + (lane >> 3)) * PROW + (lane & 7) * 8);
    const int spar = (q + 1) & 1;
    const LAS unsigned char* tb = lds + L_BIAS + h * BIAS_H + spar * BIAS_S + (31 - q + 4 * hi - spar) * 4;
    const int sw = (q >> 1) & 7;
    int kaddr[4];
#pragma unroll
    for (int d0 = 0; d0 < 4; ++d0) kaddr[d0] = L_K + q * 128 + ((((2 * d0) | hi) ^ sw) << 4);
    f32x16 p[5];
#pragma unroll
    for (int dl = 0; dl < 5; ++dl) {
        const int kb = qi + dl;
#pragma unroll
        for (int g4 = 0; g4 < 4; ++g4) { const f32x2 b0 = *(const LAS f32x2*)(tb + (32 * dl + 8 * g4) * 4), b1 = *(const LAS f32x2*)(tb + (32 * dl + 8 * g4 + 2) * 4);
            p[dl][4 * g4 + 0] = b0.x; p[dl][4 * g4 + 1] = b0.y; p[dl][4 * g4 + 2] = b1.x; p[dl][4 * g4 + 3] = b1.y; }
#pragma unroll
        for (int d0 = 0; d0 < 4; ++d0) { const bf16x8 kf = *(const LAS bf16x8*)(lds + kaddr[d0] + kb * 4096); p[dl] = __builtin_amdgcn_mfma_f32_32x32x16_bf16(kf, qf[d0], p[dl], 0, 0, 0); }
        if (first && kb < 4) {
#pragma unroll
            for (int r = 0; r < 16; ++r) p[dl][r] = NEG; }
    }
    float mx = sink2;
#pragma unroll
    for (int dl = 0; dl < 5; ++dl)
#pragma unroll
        for (int r = 0; r < 16; ++r) mx = fmaxf(mx, p[dl][r]);
    mx = xhalf_max(mx);
    float ls = 0.f;
#pragma unroll
    for (int dl = 0; dl < 5; ++dl)
#pragma unroll
        for (int r = 0; r < 16; ++r) { p[dl][r] = __builtin_amdgcn_exp2f(p[dl][r] - mx); ls += p[dl][r]; }
    ls = xhalf_sum(ls) + __builtin_amdgcn_exp2f(sink2 - mx);
    const float inv = __builtin_amdgcn_rcpf(ls);
    f32x16 o[2]; o[0] = f32x16{}; o[1] = f32x16{};
    const LAS unsigned char* vb = lds + L_V + (4 * hi + ((lane & 15) >> 2)) * 64 + ((lane >> 4) & 1) * 32 + (lane & 3) * 8;
#pragma unroll
    for (int dl = 0; dl < 5; ++dl) {
        const int kb = qi + dl;
#pragma unroll
        for (int s = 0; s < 2; ++s) {
            union { unsigned u[4]; bf16x8 v; } pa;
#pragma unroll
            for (int i = 0; i < 4; ++i) pa.u[i] = cvtpk(p[dl][8 * s + 2 * i] * inv, p[dl][8 * s + 2 * i + 1] * inv);
#pragma unroll
            for (int db = 0; db < 2; ++db) { const LAS unsigned char* vp = vb + db * 16384 + (32 * kb + 16 * s) * 64;
                const s16x4 lo = vtr(vp), hh = vtr(vp + 512);
                const bf16x8 vf = (bf16x8){lo[0], lo[1], lo[2], lo[3], hh[0], hh[1], hh[2], hh[3]};
                o[db] = __builtin_amdgcn_mfma_f32_32x32x16_bf16(pa.v, vf, o[db], 0, 0, 0); }
        }
    }
    LAS bf16* stg = (LAS bf16*)(lds + L_OST + wave * 8192);
#pragma unroll
    for (int r = 0; r < 16; ++r) { const int orow = crow(r, hi);
#pragma unroll
        for (int db = 0; db < 2; ++db) stg[orow * 64 + db * 32 + q] = (bf16)cvtpk(o[db][r], o[db][r]); }
#pragma unroll
    for (int i = 0; i < 4; ++i) { const int row = i * 8 + (lane >> 3), ch = lane & 7;
        const v4u ov = *(const LAS v4u*)(stg + row * 64 + ch * 8);
        bf16* gp = Qc + (32 * qi + row) * PROW + ch * 8;
        const v4u gv = gl[i]; v4u w;
        w.x = cvtpk(bflo(ov.x) * bflo(gv.x), bfhi(ov.x) * bfhi(gv.x)); w.y = cvtpk(bflo(ov.y) * bflo(gv.y), bfhi(ov.y) * bfhi(gv.y));
        w.z = cvtpk(bflo(ov.z) * bflo(gv.z), bfhi(ov.z) * bfhi(gv.z)); w.w = cvtpk(bflo(ov.w) * bflo(gv.w), bfhi(ov.w) * bfhi(gv.w));
        *(v4u*)gp = w; }
#pragma unroll
    for (int d0 = 0; d0 < 4; ++d0) qf[d0] = qn[d0];
}

struct SguPre { v4u gv[8]; };
__device__ __forceinline__ void sgu_prefetch(SguPre& p, const bf16* Pt, int g, int cb, int lane) {
    const bf16* Vc = Pt + poff(0, PC_VB + g * 128 + cb * 32);
#pragma unroll
    for (int i = 0; i < 8; ++i) { const int idx = i * 64 + lane, s = idx >> 2, ch = idx & 3; p.gv[i] = *(const v4u*)(Vc + s * PROW + ch * 8); }
}
__device__ __forceinline__ void sgu_colblock(LAS unsigned char* slab, const LAS float* statL, bf16* Pt, int g, int cb, const bf16* Wt, const LAS float* lnp, const float* bsp, int lane_,
                                             SguPre& cur, bool pre, int gn, int cbn) {
    int lane = lane_; asm volatile("" : "+v"(lane));
    const int q = lane & 31, hi = lane >> 5;
    bf16* Uc = Pt + poff(0, PC_UG + g * 128 + cb * 32);
    v4u ugr[8];
#pragma unroll
    for (int i = 0; i < 8; ++i) { const int idx = i * 64 + lane, t = idx >> 2, ch = idx & 3; ugr[i] = *(const v4u*)(Uc + t * PROW + ch * 8); }
    const LAS float* lp = lnp + (lane & 3) * 8;
    const f32x4 g0 = *(const LAS f32x4*)lp, g1 = *(const LAS f32x4*)(lp + 4), b0 = *(const LAS f32x4*)(lp + 32), b1 = *(const LAS f32x4*)(lp + 36);
    const bf16* wrow = Wt + ((size_t)(g * 128 + q) * 128 + 8 * hi);
    bf16x8 a0[2], a3[8];
#pragma unroll
    for (int ks = 0; ks < 2; ++ks) a0[ks] = *(const bf16x8*)(wrow + 16 * ks);
#pragma unroll
    for (int ks = 0; ks < 8; ++ks) a3[ks] = *(const bf16x8*)(wrow + (size_t)96 * 128 + 16 * ks);
#pragma unroll
    for (int i = 0; i < 8; ++i) { const int idx = i * 64 + lane, s = idx >> 2, ch = idx & 3; const float mu = statL[s], rs = statL[128 + s]; const v4u w = cur.gv[i]; v4u o;
        o.x = cvtpk((bflo(w.x) - mu) * rs * g0.x + b0.x, (bfhi(w.x) - mu) * rs * g0.y + b0.y); o.y = cvtpk((bflo(w.y) - mu) * rs * g0.z + b0.z, (bfhi(w.y) - mu) * rs * g0.w + b0.w);
        o.z = cvtpk((bflo(w.z) - mu) * rs * g1.x + b1.x, (bfhi(w.z) - mu) * rs * g1.y + b1.y); o.w = cvtpk((bflo(w.w) - mu) * rs * g1.z + b1.z, (bfhi(w.w) - mu) * rs * g1.w + b1.w);
        *(LAS v4u*)(slab + s * 64 + ch * 16) = o; }
    if (pre) sgu_prefetch(cur, Pt, gn, cbn, lane);
    f32x16 acc[4];
#pragma unroll
    for (int tb = 0; tb < 4; ++tb) acc[tb] = f32x16{};
    const LAS unsigned char* vb = slab + (8 * hi + ((lane & 15) >> 2)) * 64 + ((lane >> 4) & 1) * 32 + (lane & 3) * 8;
#pragma unroll
    for (int ks = 0; ks < 8; ++ks) { const s16x4 lo = vtr(vb + (16 * ks) * 64), hh = vtr(vb + (16 * ks + 4) * 64);
        const bf16x8 bfr = (bf16x8){lo[0], lo[1], lo[2], lo[3], hh[0], hh[1], hh[2], hh[3]};
        if (ks < 2) acc[0] = __builtin_amdgcn_mfma_f32_32x32x16_bf16(a0[ks < 2 ? ks : 0], bfr, acc[0], 0, 0, 0);
        acc[3] = __builtin_amdgcn_mfma_f32_32x32x16_bf16(a3[ks], bfr, acc[3], 0, 0, 0); }
    asm volatile("" ::: "memory");
    bf16x8 a1[4], a2[6];
#pragma unroll
    for (int ks = 0; ks < 4; ++ks) a1[ks] = *(const bf16x8*)(wrow + (size_t)32 * 128 + 16 * ks);
#pragma unroll
    for (int ks = 0; ks < 6; ++ks) a2[ks] = *(const bf16x8*)(wrow + (size_t)64 * 128 + 16 * ks);
#pragma unroll
    for (int ks = 0; ks < 6; ++ks) { const s16x4 lo = vtr(vb + (16 * ks) * 64), hh = vtr(vb + (16 * ks + 4) * 64);
        const bf16x8 bfr = (bf16x8){lo[0], lo[1], lo[2], lo[3], hh[0], hh[1], hh[2], hh[3]};
        if (ks < 4) acc[1] = __builtin_amdgcn_mfma_f32_32x32x16_bf16(a1[ks < 4 ? ks : 0], bfr, acc[1], 0, 0, 0);
        acc[2] = __builtin_amdgcn_mfma_f32_32x32x16_bf16(a2[ks], bfr, acc[2], 0, 0, 0); }
    LAS bf16* sl16 = (LAS bf16*)slab;
#pragma unroll
    for (int tb = 0; tb < 4; ++tb)
#pragma unroll
        for (int r = 0; r < 16; ++r) { const int t = 32 * tb + crow(r, hi); const float v = acc[tb][r] + bsp[t]; sl16[t * 32 + q] = (bf16)cvtpk(v, v); }
#pragma unroll
    for (int i = 0; i < 8; ++i) { const int idx = i * 64 + lane, t = idx >> 2, ch = idx & 3;
        const v4u mv = *(const LAS v4u*)(slab + t * 64 + ch * 16);
        bf16* up = Uc + t * PROW + ch * 8; const v4u uv = ugr[i]; v4u w;
        w.x = cvtpk(bflo(mv.x) * bflo(uv.x), bfhi(mv.x) * bfhi(uv.x)); w.y = cvtpk(bflo(mv.y) * bflo(uv.y), bfhi(mv.y) * bfhi(uv.y));
        w.z = cvtpk(bflo(mv.z) * bflo(uv.z), bfhi(mv.z) * bfhi(uv.z)); w.w = cvtpk(bflo(mv.w) * bflo(uv.w), bfhi(mv.w) * bfhi(uv.w));
        *(v4u*)up = w; }
}
}

__device__ __forceinline__ void p2_mix_mfma(const Frame& F0, const Args& a, int l) {
    const Frame F = reframe(F0);
    bf16* P = (bf16*)(a.ws + WS_P);
    LAS unsigned char* lds = F.lds;
    LAS float* statL = (LAS float*)(lds + mix::L_STAT);
    const int tid = F.tid, lane = F.lane, wave = F.wave;
    const bf16* Wt = (const bf16*)(a.ws + WS_WT) + (size_t)l * 8 * 128 * 128;
    for (int t = blockIdx.x; t < M / 128; t += F.G) {
        const int tok0 = t * 128; const bool first = (t & 63) == 0;
        if (tid < 128) { const float* sp = (const float*)(a.ws + WS_ST) + ((size_t)l * M + tok0 + tid) * 2; const float s1 = sp[0], s2 = sp[1];
            const float mu = s1 * (1.f / D), var = fmaxf(s2 * (1.f / D) - mu * mu, 0.f); statL[tid] = mu; statL[128 + tid] = 1.0f / sqrtf(var + EPS); }
        v4u kvr[4], vvr[4];
#define KV_FETCH(hk_, R, COL) do { _Pragma("unroll") for (int i = 0; i < 4; ++i) { const int idx = tid + 512 * i, j = idx >> 3, ch = idx & 7; R[i] = (v4u){0u, 0u, 0u, 0u}; \
            if (!first || j >= 128) R[i] = *(const v4u*)(P + poff(tok0 - 128 + (j & 128), (COL) + (hk_) * 64) + (j & 127) * PROW + ch * 8); } } while (0)
        KV_FETCH(0, kvr, PC_K); KV_FETCH(0, vvr, PC_V);
        if (t == (int)blockIdx.x) {
        for (int c = tid; c < 28672 / 16; c += 512) *(LAS v4u*)(lds + mix::L_BIAS + c * 16) = *(const v4u*)(a.ws + WS_TY + c * 16);
        }
        for (int hk = 0; hk < NKV; ++hk) {
            const int h = hk * 8 + wave; const float sink2 = a.sinks[l * NH + h] * LOG2E;
            mix::bf16x8 qf[4];
            bf16* Qc = P + poff(tok0, PC_Q + h * 64); const bf16* Gc = P + poff(tok0, PC_GA + h * 64);
            { const bf16* qrow = Qc + (lane & 31) * PROW + 8 * (lane >> 5);
#pragma unroll
                for (int d0 = 0; d0 < 4; ++d0) qf[d0] = *(const mix::bf16x8*)(qrow + 16 * d0); }
            __syncthreads();
#pragma unroll
            for (int i = 0; i < 4; ++i) { const int idx = tid + 512 * i, j = idx >> 3, ch = idx & 7;
                *(LAS v4u*)(lds + mix::L_K + j * 128 + ((ch ^ ((j >> 1) & 7)) << 4)) = kvr[i];
                *(LAS v4u*)(lds + mix::L_V + (ch >> 2) * 16384 + j * 64 + (ch & 3) * 16) = vvr[i]; }
            __syncthreads();
#pragma unroll 1
            for (int qi = 0; qi < 3; ++qi) mix::attn_item(lds, Qc, Gc, first, h, qi, sink2, lane, wave, qf, true);
            if (hk + 1 < NKV) { KV_FETCH(hk + 1, kvr, PC_K); KV_FETCH(hk + 1, vvr, PC_V); }
            mix::attn_item(lds, Qc, Gc, first, h, 3, sink2, lane, wave, qf, false);
        }
#undef KV_FETCH
        mix::SguPre spre; mix::sgu_prefetch(spre, P + poff(tok0, 0), wave >> 2, wave & 3, lane);
        LAS float* lnp = (LAS float*)(lds + mix::L_BIAS + wave * 1024);
        { const int bi = lane >> 4, which = (lane >> 3) & 1, chn = lane & 7; const float* src = (which ? a.ln_b : a.ln_g) + l * D + (2 * bi + (wave >> 2)) * 128 + (wave & 3) * 32 + chn * 4;
          *(LAS f32x4*)(lnp + bi * 64 + which * 32 + chn * 4) = *(const f32x4*)src; }
#pragma unroll 1
        for (int i = 0; i < 4; ++i) { const int g = 2 * i + (wave >> 2), cb = wave & 3;
            mix::sgu_colblock(lds + mix::L_OST + wave * 8192, statL, P + poff(tok0, 0), g, cb, Wt, lnp + i * 64, a.b_sp + ((size_t)l * 8 + g) * 128, lane, spre, i < 3, g + 2, cb); }
        __syncthreads();
    }
}

__global__ void __launch_bounds__(NWAVES * 64, 2) fwd_kernel(Args args) {
    extern __shared__ __attribute__((aligned(16))) unsigned char lds_raw[];
    Frame F;
    F.lds = (LAS unsigned char*)lds_raw;
    F.tid = threadIdx.x; F.lane = F.tid & 63; F.wave = __builtin_amdgcn_readfirstlane(F.tid >> 6);
    F.G = GRID; { const int bx = blockIdx.x; F.vcu = (bx % 8) * (GRID / 8) + bx / 8; }
    unsigned* ctl = (unsigned*)(args.ws + WS_CTL);
    for (int u = F.tid; u < (LDS_BYTES - LDSCTL_OFF) / 4; u += NWAVES * 64) ((LAS unsigned*)(F.lds + LDSCTL_OFF))[u] = 0u;
    __syncthreads();
    XcdBarrier bar = xcd_barrier_post(ctl + CW_BAR, (volatile LAS unsigned*)(F.lds + MISC_OFF) + 8);
    const int lo = args.ph_lo, hi = args.ph_hi;
    int ph = 0;
#define PHASE_BEGIN if (lo <= ph && ph < hi) {
#define PHASE_END   if (ph + 1 < hi) xcd_barrier(bar, F.wave); } ++ph;
#define PHASE_END_C(c) if ((c) && ph + 1 < hi) xcd_barrier(bar, F.wave); } ++ph;

    PHASE_BEGIN p0_prologue(F, args); PHASE_END
    bf16* H = (bf16*)(args.ws + WS_H); bf16* P = (bf16*)(args.ws + WS_P);
    for (int l = 0; l < DEPTH; ++l) {
        int bx = blockIdx.x; asm volatile("" : "+s"(bx));
        PHASE_BEGIN
            pg8::Gemm g{H, (const bf16*)(args.ws + WS_BT1 + l * BT1_L), M, INC, D, HW_BLOCKED ? 64 : D, HW_BLOCKED ? 64 : D, HW_BLOCKED ? (size_t)16384 : (size_t)128, HW_BLOCKED ? (size_t)(D / 64) * 16384 : (size_t)128 * D * 2, HW_BLOCKED ? (size_t)16384 : (size_t)128, HW_BLOCKED ? (size_t)(D / 64) * 16384 : (size_t)128 * D * 2}; pg8::StaticOrderSplit S; S.init(M, INC, F.G, bx);
            pg8::Epi1 E{P, (float*)(args.ws + WS_ST) + (size_t)l * M * 2};
            pg8::gemm_phase<pg8::Epi1, pg8::StaticOrderSplit, true>(F.lds + RING_OFF, g, S, E, F.wave);
        PHASE_END
        PHASE_BEGIN
            p2_mix_mfma(F, args, l);
        PHASE_END
        PHASE_BEGIN
            pg8::Gemm g{P + poff(0, PC_Q), (const bf16*)(args.ws + WS_BT2 + l * BT2_L), M, D, 2 * D, PROJ_BLOCKED ? 64 : PP, HW_BLOCKED ? 64 : 2 * D, PROJ_BLOCKED ? (size_t)16384 : (size_t)128, PROJ_BLOCKED ? (size_t)(PP / 64) * 16384 : (size_t)128 * PP * 2, HW_BLOCKED ? (size_t)16384 : (size_t)128, HW_BLOCKED ? (size_t)(2 * D / 64) * 16384 : (size_t)128 * 2 * D * 2}; pg8::StaticOrder S; S.init(M, D, F.G, bx);
            pg8::Epi2 E{P};
            pg8::gemm_phase<pg8::Epi2, pg8::StaticOrder, true>(F.lds + RING_OFF, g, S, E, F.wave);
        PHASE_END
        PHASE_BEGIN
            pg8::Gemm g{P + poff(0, PC_GA), (const bf16*)(args.ws + WS_BT3 + l * BT3_L), M, D, D, PROJ_BLOCKED ? 64 : PP, HW_BLOCKED ? 64 : D, PROJ_BLOCKED ? (size_t)16384 : (size_t)128, PROJ_BLOCKED ? (size_t)(PP / 64) * 16384 : (size_t)128 * PP * 2, HW_BLOCKED ? (size_t)16384 : (size_t)128, HW_BLOCKED ? (size_t)(D / 64) * 16384 : (size_t)128 * D * 2}; pg8::StaticOrder S; S.init(M, D, F.G, bx);
            {
                float* RS = (float*)(args.ws + WS_RS);
                pg8::PanelRms st{(unsigned long long*)(args.ws + WS_XS + l * XS_BYTES), ctl + CW_SEAM + l * SEAM_BANK, RS + (size_t)l * M, (l + 1 < DEPTH) ? RS + (size_t)(l + 1) * M : nullptr};
                pg8::EpiNorm E{H, RS + (size_t)l * M, args.pre_norm + l * D, (l + 1 < DEPTH) ? nullptr : args.out, args.post_norm + l * D, args.pre_norm + (l + 1 < DEPTH ? l + 1 : 0) * D, (l + 1 < DEPTH) ? H : nullptr, st, F.lds + XTRA_OFF};
                pg8::gemm_phase<pg8::EpiNorm, pg8::StaticOrder, true>(F.lds + RING_OFF, g, S, E, F.wave);
            }
        PHASE_END_C(l + 1 < DEPTH)
        ++ph;
    }
}

extern "C" void kernel_launch(void* const* d_in, const int* in_sizes, int n_in, void* d_out, int out_size, void* d_ws, size_t ws_size, hipStream_t stream) {
    static int grid = 0;
    if (grid == 0) {
        if (n_in != 13 || in_sizes[0] != M * D || out_size != M * D || ws_size < WS_END) { fprintf(stderr, "kernel_launch: unexpected shapes (n_in %d, in0 %d, out %d, ws %zu); nothing launched\n", n_in, n_in > 0 ? in_sizes[0] : -1, out_size, ws_size); grid = -1; return; }
        int dev = 0, cus = 0, per_cu = 0;
        if (hipGetDevice(&dev) != hipSuccess || hipDeviceGetAttribute(&cus, hipDeviceAttributeMultiprocessorCount, dev) != hipSuccess) { grid = -1; return; }
        if (hipFuncSetAttribute((const void*)fwd_kernel, hipFuncAttributeMaxDynamicSharedMemorySize, LDS_BYTES) != hipSuccess) { fprintf(stderr, "kernel_launch: hipFuncSetAttribute failed\n"); grid = -1; return; }
        if (hipOccupancyMaxActiveBlocksPerMultiprocessor(&per_cu, (const void*)fwd_kernel, NWAVES * 64, LDS_BYTES) != hipSuccess || per_cu < 1) fprintf(stderr, "kernel_launch: occupancy query reports %d\n", per_cu);
        (void)hipGetLastError();
        if (cus < GRID) { fprintf(stderr, "kernel_launch: built for a device with >= %d CUs (one resident workgroup per CU); this one has %d; nothing launched\n", GRID, cus); grid = -1; return; }
        grid = GRID;
    }
    if (grid < 0) return;
    (void)hipMemsetAsync((char*)d_ws + WS_CTL, 0, CTL_ZERO_BYTES, stream);
    (void)hipMemsetAsync((char*)d_ws + WS_ST, 0, ST_BYTES, stream);
    Args a{};
    a.x = (const float*)d_in[0]; a.rel_bias = (const float*)d_in[1]; a.pre_norm = (const float*)d_in[2]; a.post_norm = (const float*)d_in[3]; a.w_in = (const float*)d_in[4];
    a.sinks = (const float*)d_in[5]; a.ln_g = (const float*)d_in[6]; a.ln_b = (const float*)d_in[7]; a.w_sp = (const float*)d_in[8]; a.b_sp = (const float*)d_in[9];
    a.w_a = (const float*)d_in[10]; a.w_b = (const float*)d_in[11]; a.w_out = (const float*)d_in[12];
    a.out = (float*)d_out; a.ws = (unsigned char*)d_ws; a.ph_lo = 0; a.ph_hi = 1 + 5 * DEPTH;
    hipLaunchKernelGGL(fwd_kernel, dim3(grid), dim3(NWAVES * 64), LDS_BYTES, stream, a);
}
```

```cpp
#include <hip/hip_runtime.h>
#include <cstdio>
#include <cstdint>

constexpr int BATCH = 4, SEQ = 8192, D = 1024, M = BATCH * SEQ, DEPTH = 2;
constexpr int NH = 16, HD = 64, NKV = 2, WIN = 128;
constexpr int INC = 7424;
constexpr int PP = 6400;
#ifndef PROJ_BLOCKED
#define PROJ_BLOCKED 1
#endif
__host__ __device__ __forceinline__ size_t poff(int row, int col) {
#if PROJ_BLOCKED
    return ((size_t)((row >> 7) * (PP / 64) + (col >> 6)) << 13) + (size_t)(((row & 127) << 6) + (col & 63));
#else
    return (size_t)row * PP + col;
#endif
}
#ifndef HW_BLOCKED
#define HW_BLOCKED 1
#endif
__host__ __device__ __forceinline__ size_t boff(int row, int col, int kb) {
#if HW_BLOCKED
    return ((size_t)((row >> 7) * kb + (col >> 6)) << 13) + (size_t)(((row & 127) << 6) + (col & 63));
#else
    return (size_t)row * (kb * 64) + col;
#endif
}
#if PROJ_BLOCKED
constexpr size_t PO_R128 = (size_t)(PP / 64) << 13, PO_R16 = 16 * 64, PO_C128 = (size_t)2 << 13, PO_C1024 = (size_t)16 << 13;
constexpr int PROW = 64;
#else
constexpr size_t PO_R128 = (size_t)128 * PP, PO_R16 = (size_t)16 * PP, PO_C128 = 128, PO_C1024 = 1024;
constexpr int PROW = PP;
#endif
constexpr int PC_Q = 0, PC_UG = 1024, PC_K = 2048, PC_V = 2176, PC_GA = 2304, PC_VB = 3328, PC_MGA = 4352, PC_MGB = 5376;
constexpr float EPS = 1e-6f;
constexpr float LOG2E = 1.4426950408889634f;
constexpr float C2 = 0.125f * LOG2E;

__device__ __forceinline__ int lane_id_fresh() { unsigned z = 0; asm volatile("" : "+v"(z)); return (int)__builtin_amdgcn_mbcnt_hi(~0u, __builtin_amdgcn_mbcnt_lo(~0u, z)); }

namespace pg8 {
#define PG8_LAS __attribute__((address_space(3)))
typedef unsigned short bf16_t;
typedef short bf16x8 __attribute__((ext_vector_type(8)));
typedef float f32x4 __attribute__((ext_vector_type(4)));
typedef float f32x2 __attribute__((ext_vector_type(2)));
typedef unsigned u32x4 __attribute__((ext_vector_type(4)));
#ifndef WGM1
#define WGM1 4
#endif
constexpr int BM = 256, BK = 64, HALF = 128, HTB = HALF * BK * 2, STAGE_BYTES = 8 * HTB, NXCD = 8;

__host__ __device__ __forceinline__ int lds_byte(int r, int c) { const int st = (r >> 4) * 2 + (c >> 5), rr = r & 15, cc = c & 31, ob = rr * 64 + cc * 2; return st * 1024 + (ob ^ (((ob >> 9) & 1) << 5)); }
__host__ __device__ __forceinline__ void stage_rc(int b, int& R, int& C) { const int st = b / 1024, sb = b % 1024, swz = sb ^ (((sb >> 9) & 1) << 5); R = (st >> 1) * 16 + swz / 64; C = (st & 1) * 32 + (swz % 64) / 2; }
__host__ __device__ __forceinline__ int perm32(int rho) { const int n = rho >> 4, i = rho & 15; return 8 * (i >> 2) + 4 * n + (i & 3); }

struct Unit { int pm, pn; };
struct Gemm { const bf16_t* A; const bf16_t* Bt; int M, N, K, lda, ldb; size_t kstepA, hstepA, kstepB, hstepB; };

template <bool SPLIT_TAIL, int WGM> struct StaticOrderT {
    int nM, nN, nwg, G, c;
    __host__ __device__ void init(int M_, int N_, int G_, int c_) { nM = M_ / BM; nN = N_ / BM; nwg = nM * nN; G = G_; c = c_; }
    __host__ __device__ bool next(int i, Unit& u) const {
        long L = (long)i * G + c; int hb = 0;
        if (SPLIT_TAIL && (nwg - (long)i * G) * 2 == G) { hb = (c >= G / 2) ? 2 : 1; if (hb == 2) L -= G / 2; }
        if (L >= nwg) return false;
        int wgid = (int)L; { const int q = nwg / NXCD, r = nwg % NXCD, xcd = wgid % NXCD, off = wgid / NXCD; wgid = (xcd < r ? xcd * (q + 1) : r * (q + 1) + (xcd - r) * q) + off; }
        const int nig = WGM * nN, gid = wgid / nig, fm = gid * WGM, gsz = (nM - fm) < WGM ? (nM - fm) : WGM;
        u.pm = fm + ((wgid % nig) % gsz); u.pn = ((wgid % nig) / gsz) | (hb << 8); return true;
    }
};
typedef StaticOrderT<false, 4> StaticOrder;
typedef StaticOrderT<true, WGM1> StaticOrderSplit;

__device__ __forceinline__ unsigned cvt_pk_bf16(float lo, float hi) { unsigned r; asm volatile("v_cvt_pk_bf16_f32 %0, %1, %2" : "=v"(r) : "v"(lo), "v"(hi)); return r; }
__device__ __forceinline__ float bf_lo(unsigned w) { return __builtin_bit_cast(float, w << 16); }
__device__ __forceinline__ float bf_hi(unsigned w) { return __builtin_bit_cast(float, w & 0xffff0000u); }
__device__ __forceinline__ f32x2 gelu_pk(f32x2 v) {
    const f32x2 av = __builtin_elementwise_abs(v), d = av * 0.2316418882f + 1.0f;
    f32x2 t; t.x = __builtin_amdgcn_rcpf(d.x); t.y = __builtin_amdgcn_rcpf(d.y);
    f32x2 q = t * 0.5307027145f + (-0.7265760135f); q = q * t + 0.7107068705f; q = q * t + (-0.142248368f); q = q * t + 0.127414796f; q = q * t;
    const f32x2 s = (v * v) * (-0.72134752044f);
    f32x2 e; e.x = __builtin_amdgcn_exp2f(s.x); e.y = __builtin_amdgcn_exp2f(s.y);
    const f32x2 m = v * (q * e), r = v - m;
    f32x2 o; o.x = v.x < 0.f ? m.x : r.x; o.y = v.y < 0.f ? m.y : r.y; return o;
}
__device__ __forceinline__ float sigmoidf_(float x) { return __builtin_amdgcn_rcpf(1.0f + __builtin_amdgcn_exp2f(-x * LOG2E)); }
__device__ __forceinline__ f32x4 gelu4(f32x4 v) { f32x2 a = gelu_pk((f32x2){v[0], v[1]}), b = gelu_pk((f32x2){v[2], v[3]}); return (f32x4){a.x, a.y, b.x, b.y}; }
__device__ __forceinline__ f32x4 sig4(f32x4 v) { return (f32x4){sigmoidf_(v[0]), sigmoidf_(v[1]), sigmoidf_(v[2]), sigmoidf_(v[3])}; }
__device__ __forceinline__ f32x4 silu4(f32x4 v) { return v * sig4(v); }
__device__ __forceinline__ unsigned cvtpk_n(float lo, float hi) { typedef __bf16 bf2 __attribute__((ext_vector_type(2))); f32x2 v = {lo, hi}; bf2 b = __builtin_convertvector(v, bf2); return __builtin_bit_cast(unsigned, b); }
__device__ __forceinline__ u32x4 pack8(f32x4 v0, f32x4 v1) { u32x4 w; w.x = cvtpk_n(v0[0], v0[1]); w.y = cvtpk_n(v0[2], v0[3]); w.z = cvtpk_n(v1[0], v1[1]); w.w = cvtpk_n(v1[2], v1[3]); return w; }


template <int N> __device__ __forceinline__ void sig_n(float (&v)[N]) {
#pragma unroll
    for (int i = 0; i < N; ++i) v[i] = __builtin_amdgcn_exp2f(v[i] * (-LOG2E));
#pragma unroll
    for (int i = 0; i < N; ++i) v[i] = __builtin_amdgcn_rcpf(v[i] + 1.0f);
}
template <int N> __device__ __forceinline__ void silu_n(float (&v)[N]) {
    float s[N];
#pragma unroll
    for (int i = 0; i < N; ++i) s[i] = v[i];
    sig_n<N>(s);
#pragma unroll
    for (int i = 0; i < N; ++i) v[i] *= s[i];
}
template <int N> __device__ __forceinline__ void gelu_n(float (&v)[N]) {
    float t[N], e[N];
#pragma unroll
    for (int i = 0; i < N; ++i) t[i] = __builtin_amdgcn_rcpf(__builtin_fabsf(v[i]) * 0.2316418882f + 1.0f);
#pragma unroll
    for (int i = 0; i < N; ++i) e[i] = __builtin_amdgcn_exp2f(v[i] * v[i] * (-0.72134752044f));
#pragma unroll
    for (int i = 0; i < N; ++i) { float q = t[i] * 0.5307027145f + (-0.7265760135f); q = q * t[i] + 0.7107068705f; q = q * t[i] + (-0.142248368f); q = q * t[i] + 0.127414796f; q = q * t[i];
        const float m = v[i] * (q * e[i]); v[i] = v[i] < 0.f ? m : v[i] - m; }
}
template <int KIND> __device__ __forceinline__ void epi1_tile(const f32x4 (&acc)[2][2][4][2], bf16_t* base, float* strow, int fq, int half) {
#pragma unroll
    for (int ai = 0; ai < 2; ++ai) { if (half >= 0 && half != ai) continue;
#pragma unroll
        for (int m = 0; m < 4; ++m) { bf16_t* rowp = base + ai * PO_R128 + m * PO_R16;
            float v[16];
#pragma unroll
            for (int bj = 0; bj < 2; ++bj)
#pragma unroll
                for (int n = 0; n < 2; ++n)
#pragma unroll
                    for (int i = 0; i < 4; ++i) v[bj * 8 + n * 4 + i] = acc[ai][bj][m][n][i];
            if (KIND == 6) {
                sig_n<16>(v);
                unsigned qv[16];
#pragma unroll
                for (int i = 0; i < 16; ++i) { const unsigned q = (unsigned)(v[i] * 256.0f); qv[i] = q > 255u ? 255u : q; }
                u32x4 w;
                w.x = qv[0] | (qv[8] << 8) | (qv[1] << 16) | (qv[9] << 24); w.y = qv[2] | (qv[10] << 8) | (qv[3] << 16) | (qv[11] << 24);
                w.z = qv[4] | (qv[12] << 8) | (qv[5] << 16) | (qv[13] << 24); w.w = qv[6] | (qv[14] << 8) | (qv[7] << 16) | (qv[15] << 24);
                __builtin_nontemporal_store(w, (u32x4*)rowp);
            } else if (KIND == 1) {
                float u[8], g[8];
#pragma unroll
                for (int i = 0; i < 8; ++i) { u[i] = v[i]; g[i] = v[8 + i]; }
                gelu_n<8>(u); silu_n<8>(g);
                u32x4 w; w.x = cvtpk_n(u[0] * g[0], u[1] * g[1]); w.y = cvtpk_n(u[2] * g[2], u[3] * g[3]); w.z = cvtpk_n(u[4] * g[4], u[5] * g[5]); w.w = cvtpk_n(u[6] * g[6], u[7] * g[7]);
                __builtin_nontemporal_store(w, (u32x4*)rowp);
            } else {
                if (KIND == 0) {
#pragma unroll
                    for (int i = 0; i < 16; ++i) v[i] *= C2; }
                else if (KIND == 3) silu_n<16>(v);
                else if (KIND == 4) { gelu_n<16>(v);
                    float s1 = 0.f, s2 = 0.f;
#pragma unroll
                    for (int i = 0; i < 16; ++i) { s1 += v[i]; s2 += v[i] * v[i]; }
                    s1 += __shfl_xor(s1, 16); s2 += __shfl_xor(s2, 16); s1 += __shfl_xor(s1, 32); s2 += __shfl_xor(s2, 32);
                    if (fq == 0) { float* sp = strow + 2 * (ai * HALF + m * 16); __hip_atomic_fetch_add(sp, s1, __ATOMIC_RELAXED, __HIP_MEMORY_SCOPE_AGENT); __hip_atomic_fetch_add(sp + 1, s2, __ATOMIC_RELAXED, __HIP_MEMORY_SCOPE_AGENT); } }
                else if (KIND == 5) sig_n<16>(v);
#pragma unroll
                for (int bj = 0; bj < 2; ++bj) { u32x4 w; w.x = cvtpk_n(v[bj * 8 + 0], v[bj * 8 + 1]); w.y = cvtpk_n(v[bj * 8 + 2], v[bj * 8 + 3]); w.z = cvtpk_n(v[bj * 8 + 4], v[bj * 8 + 5]); w.w = cvtpk_n(v[bj * 8 + 6], v[bj * 8 + 7]);
                    __builtin_nontemporal_store(w, (u32x4*)(rowp + bj * 32)); }
            }
        }
    }
}
struct Epi1 {
    static constexpr bool PERM = true, HAS_MID = false, HALF_OK = true;
    bf16_t* P; float* stat; unsigned* kvf; PG8_LAS unsigned* kvc; unsigned* kvw;
    __device__ __forceinline__ void mid(f32x4 (&)[2][2][4][2], const Unit&, int, int, int, int) const {}
    __device__ __forceinline__ void operator()(f32x4 (&acc)[2][2][4][2], const Unit& u, int wr, int wc, int fr, int fq) const {
        const int pn = u.pn & 255, half = (u.pn >> 8) - 1; int kind, ocol;
        if (pn < 4) { kind = 0; ocol = PC_Q + 256 * pn; } else if (pn < 12) { kind = 1; ocol = PC_UG + 128 * (pn - 4); } else if (pn == 12) { kind = 2; ocol = PC_K; }
        else if (pn < 17) { kind = 3; ocol = PC_GA + 256 * (pn - 13); } else if (pn < 21) { kind = 4; ocol = PC_VB + 256 * (pn - 17); } else { kind = 6; ocol = PC_MGA + 128 * (pn - 21); }
        const bool paired = (kind == 1 || kind == 6);
        bf16_t* base = P + poff(u.pm * BM + wr * 64 + fr, ocol + (paired ? wc * 32 : wc * 64) + 8 * fq);
        float* strow = stat + 2 * (size_t)(u.pm * BM + wr * 64 + fr);
        switch (kind) {
            case 0: epi1_tile<0>(acc, base, strow, fq, half); break;
            case 1: epi1_tile<1>(acc, base, strow, fq, half); break;
            case 2: if (kvf != nullptr && (u.pm & 31) == 15) {
                        if (kvw != nullptr && half != 0) { unsigned sp_ = 0; while (__hip_atomic_load(kvw + 64 * (u.pm >> 5), __ATOMIC_RELAXED, __HIP_MEMORY_SCOPE_AGENT) == 0u) { __builtin_amdgcn_s_sleep(1); if (++sp_ > (1u << 22)) break; } }
                        epi1_tile<2>(acc, base, strow, fq, half);
                        if (half != 0) { asm volatile("s_waitcnt vmcnt(0)" ::: "memory");
                            if (lane_id_fresh() == 0) { const unsigned o = __hip_atomic_fetch_add(kvc, 1u, __ATOMIC_RELAXED, __HIP_MEMORY_SCOPE_WORKGROUP);
                                if ((o & 7u) == 7u) { __builtin_amdgcn_fence(__ATOMIC_RELEASE, "agent"); asm volatile("s_waitcnt vmcnt(0)" ::: "memory"); __hip_atomic_fetch_add(kvf + 64 * (u.pm >> 5), 8u, __ATOMIC_RELAXED, __HIP_MEMORY_SCOPE_AGENT); } } } }
                    else epi1_tile<2>(acc, base, strow, fq, half);
                    break;
            case 3: epi1_tile<3>(acc, base, strow, fq, half); break;
            case 4: epi1_tile<4>(acc, base, strow, fq, half); break;
            default: epi1_tile<6>(acc, base, strow, fq, half); break;
        }
    }
};
__device__ __forceinline__ float gate_ratio(unsigned w) { return ((float)(w & 255u) + 0.5f) * __builtin_amdgcn_rcpf((float)((w >> 8) & 255u) + 0.5f); }
__device__ __forceinline__ float gate_b(unsigned w) { return ((float)((w >> 8) & 255u) + 0.5f) * (1.0f / 256.0f); }
struct Epi2 {
    static constexpr bool PERM = true, HAS_MID = true, HALF_OK = false;
    bf16_t* P;
    __device__ __forceinline__ void mid(f32x4 (&acc)[2][2][4][2], const Unit& u, int wr, int wc, int fr, int fq) const {
        int opq = 0; asm volatile("" : "+v"(opq));
        const bf16_t* base = P + poff(u.pm * BM + wr * 64 + fr + opq, PC_MGA + u.pn * BM + wc * 64 + 8 * fq);
#pragma unroll
        for (int ai = 0; ai < 2; ++ai)
#pragma unroll
            for (int m = 0; m < 4; ++m) { const bf16_t* rowp = base + ai * PO_R128 + m * PO_R16;
#pragma unroll
                for (int bj = 0; bj < 2; ++bj) { const u32x4 a = *(const u32x4*)(rowp + bj * 32);
                    acc[ai][bj][m][0] *= (f32x4){gate_ratio(a.x), gate_ratio(a.x >> 16), gate_ratio(a.y), gate_ratio(a.y >> 16)}; acc[ai][bj][m][1] *= (f32x4){gate_ratio(a.z), gate_ratio(a.z >> 16), gate_ratio(a.w), gate_ratio(a.w >> 16)}; }
                if (m & 1) asm volatile("" ::: "memory"); }
    }
    __device__ __forceinline__ void operator()(f32x4 (&acc)[2][2][4][2], const Unit& u, int wr, int wc, int fr, int fq) const {
        bf16_t* base = P + poff(u.pm * BM + wr * 64 + fr, u.pn * BM + wc * 64 + 8 * fq);
        constexpr size_t O_MG = (size_t)(PC_MGA / 64) * (PO_C128 / 2), O_GA = (size_t)(PC_GA / 64) * (PO_C128 / 2);
#pragma unroll
        for (int ai = 0; ai < 2; ++ai)
#pragma unroll
            for (int m = 0; m < 4; ++m) { bf16_t* rowp = base + ai * PO_R128 + m * PO_R16;
#pragma unroll
                for (int bj = 0; bj < 2; ++bj) { const u32x4 b = *(const u32x4*)(rowp + O_MG + bj * 32);
                    const f32x4 s0 = (f32x4){gate_b(b.x), gate_b(b.x >> 16), gate_b(b.y), gate_b(b.y >> 16)}, s1 = (f32x4){gate_b(b.z), gate_b(b.z >> 16), gate_b(b.w), gate_b(b.w >> 16)};
                    *(u32x4*)(rowp + O_GA + bj * 32) = pack8(acc[ai][bj][m][0] * s0, acc[ai][bj][m][1] * s1); }
                if (m & 1) asm volatile("" ::: "memory"); }
    }
};
#define PG8_RLX_AGENT __ATOMIC_RELAXED, __HIP_MEMORY_SCOPE_AGENT
struct PanelRms {
    unsigned long long* xbuf;
    unsigned* cnt;
    const float* rs_in;
    float* rsout;
    __device__ __forceinline__ void put(int ai, int m, float s0, float s1, float s2, int wr, int wc, int fr, int fq, PG8_LAS unsigned char* xl) const {
        PG8_LAS float* Pt = (PG8_LAS float*)xl;
        s0 += __shfl_xor(s0, 16); s1 += __shfl_xor(s1, 16); s2 += __shfl_xor(s2, 16); s0 += __shfl_xor(s0, 32); s1 += __shfl_xor(s1, 32); s2 += __shfl_xor(s2, 32);
        if (fq == 0) { PG8_LAS float* p = Pt + ((ai * HALF + wr * 64 + m * 16 + fr) * 3) * 4 + wc; p[0] = s0; p[4] = s1; p[8] = s2; }
    }
    __device__ __forceinline__ void finish(const Unit& u, int wr, int wc, int fr, int fq, PG8_LAS unsigned char* xl) const {
        PG8_LAS float* Pt = (PG8_LAS float*)xl; PG8_LAS f32x2* S = (PG8_LAS f32x2*)(xl + 12288);
        const int wid = wr * 4 + wc, lane = fr + 16 * fq;
        asm volatile("s_waitcnt lgkmcnt(0)" ::: "memory"); __builtin_amdgcn_s_barrier(); asm volatile("" ::: "memory");
        const int row = wid * 32 + (lane & 31);
        if (lane < 32) { float t[3];
#pragma unroll
            for (int k = 0; k < 3; ++k) { const f32x4 a = *(const PG8_LAS f32x4*)(Pt + (row * 3 + k) * 4); t[k] = (a[0] + a[1]) + (a[2] + a[3]); }
            unsigned long long* slot = xbuf + ((size_t)(u.pm * BM + row) * 4 + u.pn) * 2;
            __hip_atomic_store(slot, ((unsigned long long)__builtin_bit_cast(unsigned, t[1]) << 32) | __builtin_bit_cast(unsigned, t[0]), PG8_RLX_AGENT);
            __hip_atomic_store(slot + 1, (unsigned long long)__builtin_bit_cast(unsigned, t[2]), PG8_RLX_AGENT); }
        asm volatile("s_waitcnt vmcnt(0)" ::: "memory");
        if (lane == 0) __hip_atomic_fetch_add(cnt + 64 * u.pm, 1u, PG8_RLX_AGENT);
        if (wid == 0) { unsigned sp = 0;
            while ((unsigned)__builtin_amdgcn_readfirstlane(__hip_atomic_load(cnt + 64 * u.pm, PG8_RLX_AGENT)) < 32u) { __builtin_amdgcn_s_sleep(2); if (++sp > (1u << 22)) break; }
            __builtin_amdgcn_fence(__ATOMIC_ACQUIRE, "agent"); }
        asm volatile("s_waitcnt vmcnt(0) lgkmcnt(0)" ::: "memory"); __builtin_amdgcn_s_barrier(); asm volatile("" ::: "memory");
        if (lane < 32) { const unsigned long long* slot = xbuf + (size_t)(u.pm * BM + row) * 8; float o2 = 0.f, xgo = 0.f, go2 = 0.f;
#pragma unroll
            for (int k = 0; k < 4; ++k) { const unsigned long long w0 = __hip_atomic_load(slot + 2 * k, PG8_RLX_AGENT), w1 = __hip_atomic_load(slot + 2 * k + 1, PG8_RLX_AGENT);
                o2 += __builtin_bit_cast(float, (unsigned)w0); xgo += __builtin_bit_cast(float, (unsigned)(w0 >> 32)); go2 += __builtin_bit_cast(float, (unsigned)w1); }
            const float rs1 = 1.0f / sqrtf(o2 * (1.0f / 1024.0f) + EPS);
            const float ri = rs_in[u.pm * BM + row], sx2 = 1024.0f * (1.0f / (ri * ri) - EPS);
            const float ss2 = fmaxf(sx2 + 2.0f * rs1 * xgo + rs1 * rs1 * go2, 0.f);
            const float rs2 = 1.0f / sqrtf(ss2 * (1.0f / 1024.0f) + EPS);
            S[row] = (f32x2){rs1, rs2}; if (rsout && u.pn == 0) rsout[u.pm * BM + row] = rs2; }
        asm volatile("s_waitcnt lgkmcnt(0)" ::: "memory"); __builtin_amdgcn_s_barrier(); asm volatile("" ::: "memory");
    }
};
struct EpiNorm {
    static constexpr bool PERM = true, HAS_MID = false, HALF_OK = false;
    const bf16_t* hin; const float* rs_in; const float* gin; float* xout; const float* gpost; const float* gpre; bf16_t* hn; PanelRms st; PG8_LAS unsigned char* xl;
    __device__ __forceinline__ void mid(f32x4 (&)[2][2][4][2], const Unit&, int, int, int, int) const {}
    __device__ __forceinline__ void operator()(f32x4 (&acc)[2][2][4][2], const Unit& u, int wr, int wc, int fr, int fq) const {
        int opq = 0; asm volatile("" : "+v"(opq));
        const PG8_LAS f32x2* S = (const PG8_LAS f32x2*)(xl + 12288);
        const int wid = wr * 4 + wc, lane = fr + 16 * fq + opq;
        PG8_LAS float* gt = (PG8_LAS float*)(xl + 14336 + wid * 768);
        { const int gc = u.pn * BM + wc * 64 + lane;
          gt[lane] = gpost[gc]; gt[64 + lane] = __builtin_amdgcn_rcpf(gin[gc]); gt[128 + lane] = hn ? gpre[gc] : 0.f; }
        const int col0a = u.pn * BM + wc * 64 + 8 * fq + opq;
        asm volatile("s_waitcnt lgkmcnt(0)" ::: "memory");
#define EN_ROW(it) (((it) >> 2) * HALF + wr * 64 + ((it) & 3) * 16 + fr)
#define EN_LOAD(it, colx, HV0, HV1, RIN) do { int oq_ = 0; asm volatile("" : "+v"(oq_)); const int r_ = EN_ROW(it) + oq_; const size_t off_ = boff(u.pm * BM + r_, (colx), D / 64); \
            HV0 = *(const u32x4*)(hin + off_); HV1 = *(const u32x4*)(hin + off_ + 32); RIN = rs_in[u.pm * BM + r_]; } while (0)
        u32x4 hc0, hc1, hn0, hn1; float rc, rn;
        EN_LOAD(0, col0a, hn0, hn1, rn);
#pragma unroll
        for (int it = 0; it < 8; ++it) { const int ai = it >> 2, m = it & 3;
            hc0 = hn0; hc1 = hn1; rc = rn;
            if (it < 7) EN_LOAD(it + 1, col0a, hn0, hn1, rn);
            const float rinv = __builtin_amdgcn_rcpf(rc); float s0 = 0.f, s1 = 0.f, s2 = 0.f;
#pragma unroll
            for (int bj = 0; bj < 2; ++bj) { const u32x4 hv = bj ? hc1 : hc0;
                const PG8_LAS float* g = gt + bj * 32 + 8 * fq;
                const f32x4 gp0 = *(const PG8_LAS f32x4*)g, gp1 = *(const PG8_LAS f32x4*)(g + 4), gi0 = *(const PG8_LAS f32x4*)(g + 64), gi1 = *(const PG8_LAS f32x4*)(g + 68);
                const f32x4 x0 = (f32x4){bf_lo(hv.x), bf_hi(hv.x), bf_lo(hv.y), bf_hi(hv.y)} * gi0 * rinv, x1 = (f32x4){bf_lo(hv.z), bf_hi(hv.z), bf_lo(hv.w), bf_hi(hv.w)} * gi1 * rinv;
                const f32x4 a0 = acc[ai][bj][m][0], a1 = acc[ai][bj][m][1], g0 = a0 * gp0, g1 = a1 * gp1;
#pragma unroll
                for (int i = 0; i < 4; ++i) { s0 += a0[i] * a0[i] + a1[i] * a1[i]; s1 += x0[i] * g0[i] + x1[i] * g1[i]; s2 += g0[i] * g0[i] + g1[i] * g1[i]; } }
            st.put(ai, m, s0, s1, s2, wr, wc, fr, fq, xl); }
        int opq2 = 0; asm volatile("" : "+v"(opq2));
        const int col0 = col0a + opq2;
        EN_LOAD(0, col0, hn0, hn1, rn);
        st.finish(u, wr, wc, fr, fq, xl);
#pragma unroll
        for (int it = 0; it < 8; ++it) { const int ai = it >> 2, m = it & 3;
            hc0 = hn0; hc1 = hn1; rc = rn;
            if (it < 7) EN_LOAD(it + 1, col0, hn0, hn1, rn);
            int oq = 0; asm volatile("" : "+v"(oq));
            const int r = EN_ROW(it) + oq; const f32x2 rs = S[r]; const size_t off = (size_t)(u.pm * BM + r) * D + col0, offh = boff(u.pm * BM + r, col0, D / 64);
            const float rinv = __builtin_amdgcn_rcpf(rc);
#pragma unroll
            for (int bj = 0; bj < 2; ++bj) { const u32x4 hv = bj ? hc1 : hc0;
                const PG8_LAS float* g = gt + bj * 32 + 8 * fq;
                const f32x4 gp0 = *(const PG8_LAS f32x4*)g, gp1 = *(const PG8_LAS f32x4*)(g + 4), gi0 = *(const PG8_LAS f32x4*)(g + 64), gi1 = *(const PG8_LAS f32x4*)(g + 68);
                const f32x4 x0 = (f32x4){bf_lo(hv.x), bf_hi(hv.x), bf_lo(hv.y), bf_hi(hv.y)} * gi0 * rinv, x1 = (f32x4){bf_lo(hv.z), bf_hi(hv.z), bf_lo(hv.w), bf_hi(hv.w)} * gi1 * rinv;
                const f32x4 o0 = x0 + acc[ai][bj][m][0] * rs.x * gp0, o1 = x1 + acc[ai][bj][m][1] * rs.x * gp1;
                if (xout) { *(f32x4*)(xout + off + bj * 32) = o0; *(f32x4*)(xout + off + bj * 32 + 4) = o1; }
                if (hn) { const f32x4 gq0 = *(const PG8_LAS f32x4*)(g + 128), gq1 = *(const PG8_LAS f32x4*)(g + 132); *(u32x4*)(hn + offh + bj * 32) = pack8(o0 * rs.y * gq0, o1 * rs.y * gq1); } } }
#undef EN_ROW
#undef EN_LOAD
    }
};

template <class Epi, class Sched, bool ALIGN_EPI = false>
__device__ __forceinline__ void gemm_phase(PG8_LAS unsigned char* lds, const Gemm g, const Sched& S, const Epi& E, int wave_) {
    int wid_ = wave_; asm volatile("" : "+s"(wid_));
    const int wid = wid_, lane = lane_id_fresh(), tid = wid * 64 + lane,
              wr = wid >> 2, wc = wid & 3, fr = lane & 15, fq = lane >> 4;
    const int K = g.K, nt = K / BK;
    unsigned voffA[2], voffB[2];
#pragma unroll
    for (int i = 0; i < 2; ++i) { int R, C; stage_rc(tid * 16 + i * 8192, R, C); const int Rb = Epi::PERM ? ((R & ~31) + perm32(R & 31)) : R;
        voffA[i] = (unsigned)(R * g.lda + C) * 2u; voffB[i] = (unsigned)(Rb * g.ldb + C) * 2u; }
    const size_t kstep = g.kstepB, kstepA = g.kstepA;
    const size_t hstepA = g.hstepA, hstepB = g.hstepB;
    const size_t tstepA = 2 * hstepA, tstepB = 2 * hstepB;
    const unsigned ldsw = (unsigned)wid * 1024u;
    const int aoff = lds_byte(wr * 64 + fr, fq * 8), boff = lds_byte(wc * 32 + fr, fq * 8);
#define PG8_SA(b, h) (((b) * 2 + (h)) * HTB)
#define PG8_SB(b, h) ((4 + (b) * 2 + (h)) * HTB)
#define PG8_STAGE(bufoff, gbase, voff) do { _Pragma("unroll") for (int _i = 0; _i < 2; ++_i) \
        __builtin_amdgcn_global_load_lds((const unsigned*)((const char*)(gbase) + (voff)[_i]), (PG8_LAS unsigned*)(lds + (bufoff) + ldsw + _i * 8192), 16, 0, 0); } while (0)
#define PG8_LDA(dst, b, h) do { _Pragma("unroll") for (int m = 0; m < 4; ++m) _Pragma("unroll") for (int k = 0; k < 2; ++k) dst[m][k] = *(const PG8_LAS bf16x8*)(lds + PG8_SA(b, h) + aoff + m * 2048 + k * 1024); } while (0)
#define PG8_LDB(dst, b, h) do { _Pragma("unroll") for (int n = 0; n < 2; ++n) _Pragma("unroll") for (int k = 0; k < 2; ++k) dst[n][k] = *(const PG8_LAS bf16x8*)(lds + PG8_SB(b, h) + boff + n * 2048 + k * 1024); } while (0)
#define PG8_MMA(ai, bj, At, Bt) do { __builtin_amdgcn_s_setprio(1); _Pragma("unroll") for (int m = 0; m < 4; ++m) _Pragma("unroll") for (int n = 0; n < 2; ++n) _Pragma("unroll") for (int k = 0; k < 2; ++k) \
        acc[ai][bj][m][n] = __builtin_amdgcn_mfma_f32_16x16x32_bf16(Bt[n][k], At[m][k], acc[ai][bj][m][n], 0, 0, 0); __builtin_amdgcn_s_setprio(0); } while (0)
#define PG8_WAIT_V(n) asm volatile("s_waitcnt vmcnt(" #n ")" ::: "memory")
#define PG8_WAIT_L(n) asm volatile("s_waitcnt lgkmcnt(" #n ")" ::: "memory")
#define PG8_BAR __builtin_amdgcn_s_barrier()
#define PG8_SCHED __builtin_amdgcn_sched_barrier(0)
    Unit cur, nxt; int ui = 0;
    if (!S.next(0, cur)) return;
    f32x4 acc[2][2][4][2];
#pragma unroll
    for (int a = 0; a < 2; ++a)
#pragma unroll
        for (int b = 0; b < 2; ++b)
#pragma unroll
            for (int m = 0; m < 4; ++m)
#pragma unroll
                for (int n = 0; n < 2; ++n) acc[a][b][m][n] = (f32x4){0.f, 0.f, 0.f, 0.f};
    bf16x8 At[4][2], B0[2][2], B1[2][2];
    const char* cA = (const char*)g.A + (size_t)cur.pm * tstepA; const char* cB = (const char*)g.Bt + (size_t)(cur.pn & 255) * tstepB;
    PG8_STAGE(PG8_SB(0, 0), cB, voffB); PG8_STAGE(PG8_SB(0, 1), cB + hstepB, voffB); PG8_STAGE(PG8_SA(0, 0), cA, voffA); PG8_STAGE(PG8_SA(0, 1), cA + hstepA, voffA);
    if (wr == 1) PG8_BAR;
    PG8_WAIT_V(2); PG8_BAR;
    PG8_STAGE(PG8_SB(1, 0), cB + kstep, voffB); PG8_STAGE(PG8_SA(1, 0), cA + kstepA, voffA); PG8_STAGE(PG8_SB(1, 1), cB + hstepB + kstep, voffB);
    PG8_WAIT_V(6); PG8_BAR;
    for (;;) {
        const bool has_next = S.next(ui + 1, nxt);
        const char* nA = has_next ? (const char*)g.A + (size_t)nxt.pm * tstepA : cA; const char* nB = has_next ? (const char*)g.Bt + (size_t)(nxt.pn & 255) * tstepB : cB;
        for (int t = 0; t < nt; t += 2) {
            if constexpr (Epi::HAS_MID) { if (t == (nt >> 1)) E.mid(acc, cur, wr, wc, fr, fq); }
            const bool last = (t == nt - 2);
            const char* a1 = cA + (size_t)(t + 1) * kstepA;
            const char* a2 = last ? nA : cA + (size_t)(t + 2) * kstepA; const char* b2 = last ? nB : cB + (size_t)(t + 2) * kstep;
            const char* a3 = a2 + kstepA; const char* b3 = b2 + kstep;
            PG8_LDB(B0, 0, 0); PG8_LDB(B1, 0, 1); PG8_SCHED; PG8_LDA(At, 0, 0); PG8_STAGE(PG8_SA(1, 1), a1 + hstepA, voffA);
            PG8_WAIT_V(8); PG8_WAIT_L(0); PG8_BAR; if (!Epi::HALF_OK || (cur.pn >> 8) != 2) { PG8_MMA(0, 0, At, B0); PG8_MMA(0, 1, At, B1); } PG8_BAR; PG8_SCHED;
            PG8_LDA(At, 0, 1); PG8_STAGE(PG8_SB(0, 0), b2, voffB); PG8_STAGE(PG8_SB(0, 1), b2 + hstepB, voffB); PG8_STAGE(PG8_SA(0, 0), a2, voffA);
            PG8_WAIT_V(8); PG8_WAIT_L(0); PG8_BAR; if (!Epi::HALF_OK || (cur.pn >> 8) != 1) { PG8_MMA(1, 0, At, B0); PG8_MMA(1, 1, At, B1); } PG8_BAR; PG8_SCHED;
            PG8_LDB(B0, 1, 0); PG8_LDB(B1, 1, 1); PG8_SCHED; PG8_LDA(At, 1, 0); PG8_STAGE(PG8_SA(0, 1), a2 + hstepA, voffA);
            PG8_WAIT_V(8); PG8_WAIT_L(0); PG8_BAR; if (!Epi::HALF_OK || (cur.pn >> 8) != 2) { PG8_MMA(0, 0, At, B0); PG8_MMA(0, 1, At, B1); } PG8_BAR; PG8_SCHED;
            PG8_LDA(At, 1, 1); PG8_STAGE(PG8_SB(1, 0), b3, voffB); PG8_STAGE(PG8_SB(1, 1), b3 + hstepB, voffB); PG8_STAGE(PG8_SA(1, 0), a3, voffA);
            PG8_WAIT_V(8); PG8_WAIT_L(0); PG8_BAR; if (!Epi::HALF_OK || (cur.pn >> 8) != 1) { PG8_MMA(1, 0, At, B0); PG8_MMA(1, 1, At, B1); } PG8_BAR; PG8_SCHED;
        }
        if constexpr (ALIGN_EPI) { if (wr == 0) PG8_BAR; }
        E(acc, cur, wr, wc, fr, fq);
        if (!has_next) break;
#pragma unroll
        for (int a = 0; a < 2; ++a)
#pragma unroll
            for (int b = 0; b < 2; ++b)
#pragma unroll
                for (int m = 0; m < 4; ++m)
#pragma unroll
                    for (int n = 0; n < 2; ++n) acc[a][b][m][n] = (f32x4){0.f, 0.f, 0.f, 0.f};
        cur = nxt; cA = nA; cB = nB; ++ui;
        if constexpr (ALIGN_EPI) { if (wr == 1) PG8_BAR; }
    }
    PG8_WAIT_V(0);
    if constexpr (!ALIGN_EPI) { if (wr == 0) PG8_BAR; }
    PG8_BAR;
#undef PG8_SA
#undef PG8_SB
#undef PG8_STAGE
#undef PG8_LDA
#undef PG8_LDB
#undef PG8_MMA
#undef PG8_WAIT_V
#undef PG8_WAIT_L
#undef PG8_BAR
#undef PG8_SCHED
}
}

constexpr size_t MiB = 1u << 20;
constexpr size_t WS_CTL = 0, CTL_ZERO_BYTES = 192 * 1024;
constexpr size_t WS_TY = 192 * 1024;
constexpr size_t WS_WT = 256 * 1024;
constexpr size_t WS_BT1 = 1 * MiB;
constexpr size_t BT1_L = (size_t)INC * D * 2;
constexpr size_t WS_BT2 = 30 * MiB;
constexpr size_t BT2_L = (size_t)D * 2 * D * 2;
constexpr size_t WS_BT3 = 38 * MiB;
constexpr size_t BT3_L = (size_t)D * D * 2;
constexpr size_t WS_H = 42 * MiB;
constexpr size_t WS_P = 106 * MiB;
constexpr size_t WS_RS = 510 * MiB;
constexpr size_t WS_ST = 511 * MiB, ST_BYTES = (size_t)DEPTH * M * 2 * 4;
constexpr size_t WS_END = 511 * MiB + 512 * 1024;
static_assert(WS_BT1 + 2 * BT1_L <= WS_BT2 && WS_BT2 + 2 * BT2_L <= WS_BT3 && WS_BT3 + 2 * BT3_L <= WS_H && WS_H + (size_t)M * D * 2 <= WS_P && WS_P + (size_t)M * PP * 2 <= WS_END, "ws map");
constexpr int CW_BAR = 1024;
constexpr int CW_KVF = 6144, CW_KVW = 6144 + 1024;
constexpr int CW_SEAM = 8192, SEAM_BANK = 128 * 64;
constexpr size_t WS_XS = 506 * MiB, XS_BYTES = (size_t)M * 4 * 16;
static_assert((CW_SEAM + 4 * SEAM_BANK) * 4 <= (int)CTL_ZERO_BYTES && CTL_ZERO_BYTES <= 256 * 1024, "ctl words");

constexpr int RING_OFF = 0, RING_BYTES = 131072;
constexpr int LDSCTL_OFF = RING_BYTES, MISC_OFF = LDSCTL_OFF + 320;
constexpr int XTRA_OFF = RING_BYTES + 1024;
constexpr int LDS_BYTES = 163840;

constexpr int NWAVES = 8;
constexpr int GRID = 256;
#define GAS __attribute__((address_space(1)))
#define LAS __attribute__((address_space(3)))
typedef unsigned short bf16;
typedef unsigned v4u __attribute__((ext_vector_type(4)));
typedef float f32x4 __attribute__((ext_vector_type(4)));
#define LDS_WAIT() asm volatile("s_waitcnt lgkmcnt(0)" ::: "memory")
#define VM_WAIT() asm volatile("s_waitcnt vmcnt(0)" ::: "memory")
__device__ __forceinline__ unsigned f2bf(float f) { unsigned u = __builtin_bit_cast(unsigned, f); return (u + 0x7fffu + ((u >> 16) & 1u)) >> 16; }
__device__ __forceinline__ unsigned pk2(float lo, float hi) { typedef __bf16 bf2_t __attribute__((ext_vector_type(2))); typedef float f2_t __attribute__((ext_vector_type(2))); f2_t v = {lo, hi}; bf2_t b = __builtin_convertvector(v, bf2_t); return __builtin_bit_cast(unsigned, b); }
__device__ __forceinline__ float bflo(unsigned w) { return __builtin_bit_cast(float, w << 16); }
__device__ __forceinline__ float bfhi(unsigned w) { return __builtin_bit_cast(float, w & 0xffff0000u); }
__device__ __forceinline__ float bf1(bf16 b) { return __builtin_bit_cast(float, (unsigned)b << 16); }

#define XB_TMO      128
#define XB_XCNT(j)  (256  + 64 * (j))
#define XB_XSUB(j)  (1280 + 64 * (j))
#define XB_XGEN(j)  (2304 + 64 * (j))
#define XB_TOP      3328
#define XB_TOPGEN   3392
#define XB_LSUB(j)  (3456 + 64 * (j))
#define XCD_BAR_WORDS 4480
#define XB_SPIN_CAP (1u << 18)
__device__ __forceinline__ unsigned xb_ld(unsigned* p)              { return __hip_atomic_load(p, __ATOMIC_RELAXED, __HIP_MEMORY_SCOPE_AGENT); }
__device__ __forceinline__ unsigned xb_add(unsigned* p, unsigned v) { return __hip_atomic_fetch_add(p, v, __ATOMIC_RELAXED, __HIP_MEMORY_SCOPE_AGENT); }
__device__ __forceinline__ unsigned xb_xcc_id() { return (unsigned)__builtin_amdgcn_s_getreg((3 << 11) | 20) & 0xFu; }
#define XB_SPIN(cond, bar) do { unsigned _sp = 0; while (cond) { __builtin_amdgcn_s_sleep(1); \
    if ((++_sp & 255u) == 0u) { if (xb_ld(&(bar)[XB_TMO])) break; if (_sp > XB_SPIN_CAP) { atomicAdd(&(bar)[XB_TMO], 1u); break; } } } } while (0)
struct XcdBarrier { unsigned* bar; unsigned x; volatile LAS unsigned* st; };
__device__ __forceinline__ XcdBarrier xcd_barrier_post(unsigned* bar, volatile LAS unsigned* st) {
    XcdBarrier b; b.bar = bar; b.x = xb_xcc_id(); b.st = st;
    if (threadIdx.x == 0) st[3] = xb_add(&bar[XB_XCNT(b.x)], 1u);
    return b;
}
__device__ __forceinline__ void xcd_barrier_complete(unsigned* bar, unsigned x, unsigned& nloc, unsigned& nx, unsigned& even) {
    const unsigned G = gridDim.x * gridDim.y * gridDim.z;
    unsigned sum, cnt, mine, sp = 0u;
    for (;;) {
        sum = 0u; cnt = 0u; mine = 0u; even = 1u;
#pragma unroll
        for (unsigned j = 0; j < 16; ++j) { const unsigned c = xb_ld(&bar[XB_XCNT(j)]); sum += c; cnt += (c > 0u) ? 1u : 0u; mine = (j == x) ? c : mine; even &= (c == (j < 8u ? G / 8u : 0u)) ? 1u : 0u; }
        if (sum == G) break;
        __builtin_amdgcn_s_sleep(1);
        if ((++sp & 255u) == 0u) { if (xb_ld(&bar[XB_TMO])) break; if (sp > XB_SPIN_CAP) { atomicAdd(&bar[XB_TMO], 1u); break; } }
    }
    nloc = mine > 0u ? mine : 1u; nx = cnt > 0u ? cnt : 1u;
}
__device__ __forceinline__ void xcd_barrier(const XcdBarrier& b, int wave) {
    asm volatile("s_waitcnt vmcnt(0)" ::: "memory");
    __syncthreads();
    if (wave == 0 && lane_id_fresh() == 0) {
        unsigned* bar = b.bar;
        __builtin_amdgcn_s_waitcnt(0);
        unsigned nloc = b.st[0], nx = b.st[1];
        if (nloc == 0u) { unsigned even; xcd_barrier_complete(bar, b.x, nloc, nx, even); b.st[0] = nloc; b.st[1] = nx; b.st[2] = even; }
        const unsigned old = xb_add(&bar[XB_XSUB(b.x)], 1u);
        const unsigned gen = old / nloc;
        if (old + 1u == (gen + 1u) * nloc) {
            __builtin_amdgcn_fence(__ATOMIC_RELEASE, "agent");
            asm volatile("s_waitcnt vmcnt(0)" ::: "memory");
            const unsigned og = xb_add(&bar[XB_TOP], 1u);
            const unsigned tg = og / nx;
            if (og + 1u == (tg + 1u) * nx) xb_add(&bar[XB_TOPGEN], 1u);
            else XB_SPIN(xb_ld(&bar[XB_TOPGEN]) == tg, bar);
            __builtin_amdgcn_fence(__ATOMIC_ACQUIRE, "agent");
            xb_add(&bar[XB_XGEN(b.x)], 1u);
            asm volatile("s_waitcnt vmcnt(0)" ::: "memory");
        } else {
            XB_SPIN(xb_ld(&bar[XB_XGEN(b.x)]) == gen, bar);
            __builtin_amdgcn_fence(__ATOMIC_ACQUIRE, "agent");
            asm volatile("s_waitcnt vmcnt(0)" ::: "memory");
        }
    }
    __syncthreads();
}

__device__ __forceinline__ void xcd_barrier_local(const XcdBarrier& b, int wave) {
    asm volatile("s_waitcnt vmcnt(0)" ::: "memory");
    __syncthreads();
    if (wave == 0 && lane_id_fresh() == 0) {
        unsigned* bar = b.bar;
        __builtin_amdgcn_s_waitcnt(0);
        const unsigned nloc = b.st[0];
        const unsigned old = xb_add(&bar[XB_LSUB(b.x)], 1u);
        const unsigned target = (old / nloc + 1u) * nloc;
        if (old + 1u != target) XB_SPIN(xb_ld(&bar[XB_LSUB(b.x)]) < target, bar);
        __builtin_amdgcn_fence(__ATOMIC_ACQUIRE, "agent");
        asm volatile("s_waitcnt vmcnt(0)" ::: "memory");
    }
    __syncthreads();
}

struct Args {
    const float *x, *rel_bias, *pre_norm, *post_norm, *w_in, *sinks, *ln_g, *ln_b, *w_sp, *b_sp, *w_a, *w_b, *w_out;
    float* out; unsigned char* ws; int ph_lo, ph_hi;
};
struct Frame { LAS unsigned char* lds; int tid, lane, wave, vcu, G; };

__device__ __forceinline__ Frame reframe(const Frame& F0) { Frame F = F0; asm volatile("" : "+s"(F.wave), "+s"(F.vcu)); F.lane = lane_id_fresh(); F.tid = F.wave * 64 + F.lane; return F; }
__device__ __forceinline__ float wave_sum(float v) {
#pragma unroll
    for (int o = 1; o < 64; o <<= 1) v += __shfl_xor(v, o);
    return v;
}
__device__ __forceinline__ void transpose_item(const float* W, int ldw, int k0, int n0, bf16* WT, int ldt, int drow0, int dk0, LAS float* scr, int lane) {
    f32x4 wv[8];
#pragma unroll
    for (int i = 0; i < 8; ++i) { const int kk = 8 * i + (lane >> 3); wv[i] = __builtin_nontemporal_load((const f32x4*)(W + (size_t)(k0 + kk) * ldw + n0 + 4 * (lane & 7))); }
#pragma unroll
    for (int i = 0; i < 8; ++i) { const int kk = 8 * i + (lane >> 3); LAS float* d = scr + kk * 33 + 4 * (lane & 7); d[0] = wv[i].x; d[1] = wv[i].y; d[2] = wv[i].z; d[3] = wv[i].w; }
    LDS_WAIT(); asm volatile("" ::: "memory");
    const int c = lane & 7;
#pragma unroll
    for (int j = 0; j < 4; ++j) { const int n = (lane >> 3) + 8 * j; const LAS float* s = scr + (8 * c) * 33 + n;
        v4u o; o.x = pk2(s[0 * 33], s[1 * 33]); o.y = pk2(s[2 * 33], s[3 * 33]); o.z = pk2(s[4 * 33], s[5 * 33]); o.w = pk2(s[6 * 33], s[7 * 33]);
        *(GAS v4u*)(WT + boff(drow0 + n, dk0 + k0 + 8 * c, ldt / 64)) = o; }
    LDS_WAIT(); asm volatile("" ::: "memory");
}
__host__ __device__ __forceinline__ int tile_perm(int cc) { return 128 * ((cc >> 5) & 1) + 32 * (cc >> 6) + (cc & 31); }
__device__ __forceinline__ int bt1_row(int n) {
    int r;
    if (n < 1024) r = n;
    else if (n < 1152) r = 3072 + (n - 1024);
    else if (n < 1280) r = 3200 + (n - 1152);
    else if (n < 2304) r = 3328 + (n - 1280);
    else if (n < 3328) { const int c = n - 2304; return 1024 + 256 * (c >> 7) + (c & 127); }
    else if (n < 4352) r = 4352 + (n - 3328);
    else if (n < 5376) { const int c = n - 4352; return 1024 + 256 * (c >> 7) + 128 + (c & 127); }
    else if (n < 6400) { const int c = n - 5376; return 5376 + 256 * (c >> 7) + (c & 127); }
    else { const int c = n - 6400; return 5376 + 256 * (c >> 7) + 128 + (c & 127); }
    return (r & ~255) + tile_perm(r & 255);
}
__device__ __forceinline__ float pair_swap(float x) { return __builtin_bit_cast(float, __builtin_amdgcn_mov_dpp(__builtin_bit_cast(int, x), 0xB1, 0xF, 0xF, true)); }
__device__ __forceinline__ float rms_row_to_bf16(const f32x4 (&v)[4], const float* g, bf16* Hb, int row, int lane) {
    float s2 = 0.f;
#pragma unroll
    for (int j = 0; j < 4; ++j) s2 += (v[j].x * v[j].x + v[j].y * v[j].y) + (v[j].z * v[j].z + v[j].w * v[j].w);
    const float rstd = 1.0f / sqrtf(wave_sum(s2) * (1.f / D) + EPS);
    const bool odd = lane & 1; const int cbase = 256 * (lane & 1) + 8 * (lane >> 1);
#pragma unroll
    for (int jj = 0; jj < 2; ++jj) { const f32x4 c0 = v[2 * jj], c1 = v[2 * jj + 1];
        f32x4 snd, rcv;
#pragma unroll
        for (int i = 0; i < 4; ++i) snd[i] = odd ? c0[i] : c1[i];
#pragma unroll
        for (int i = 0; i < 4; ++i) rcv[i] = pair_swap(snd[i]);
        f32x4 lo, hi;
#pragma unroll
        for (int i = 0; i < 4; ++i) { lo[i] = odd ? rcv[i] : c0[i]; hi[i] = odd ? c1[i] : rcv[i]; }
        const f32x4 g0 = *(const f32x4*)(g + 512 * jj + cbase), g1 = *(const f32x4*)(g + 512 * jj + cbase + 4);
        v4u o; o.x = pk2(lo.x * rstd * g0.x, lo.y * rstd * g0.y); o.y = pk2(lo.z * rstd * g0.z, lo.w * rstd * g0.w); o.z = pk2(hi.x * rstd * g1.x, hi.y * rstd * g1.y); o.w = pk2(hi.z * rstd * g1.z, hi.w * rstd * g1.w);
        *(GAS v4u*)(Hb + boff(row, 512 * jj + cbase, D / 64)) = o; }
    return rstd;
}

__device__ __forceinline__ int t5_bucket(int d) {
    if (d < 16) return d;
    int b = 16;
    b += (d >= 19); b += (d >= 21); b += (d >= 24); b += (d >= 27); b += (d >= 31); b += (d >= 35); b += (d >= 40); b += (d >= 46);
    b += (d >= 52); b += (d >= 59); b += (d >= 67); b += (d >= 77); b += (d >= 87); b += (d >= 99); b += (d >= 113);
    return b;
}

__device__ __forceinline__ void p0_prologue(const Frame& F0, const Args& a) {
    const Frame F = reframe(F0);
    LAS float* scr = (LAS float*)(F.lds + RING_OFF + F.wave * 16384);
    const int gw = F.vcu * NWAVES + F.wave, NGW = F.G * NWAVES;
    constexpr int I_IN = (D / 64) * (INC / 32), I_SQ = (D / 64) * (D / 32);
    constexpr int PER_L = I_IN + 3 * I_SQ, NITEMS = DEPTH * PER_L;
    bf16* ws16 = (bf16*)a.ws;
    for (int it = F.wave * F.G + F.vcu; it < NITEMS; it += NGW) {
        const int l = it / PER_L; int r = it % PER_L;
        if (r < I_IN) { const int nblk = INC / 32, kb = r / nblk, nb = r % nblk;
            transpose_item(a.w_in + (size_t)l * D * INC, INC, 64 * kb, 32 * nb, (bf16*)(a.ws + WS_BT1 + l * BT1_L), D, bt1_row(32 * nb), 0, scr, F.lane); continue; }
        r -= I_IN;
        const int which = r / I_SQ; r %= I_SQ; const int kb = r / (D / 32), nb = r % (D / 32);
        if (which == 0) transpose_item(a.w_a + (size_t)l * D * D, D, 64 * kb, 32 * nb, (bf16*)(a.ws + WS_BT2 + l * BT2_L), 2 * D, ((32 * nb) & ~255) + tile_perm((32 * nb) & 255), 0, scr, F.lane);
        else if (which == 1) transpose_item(a.w_b + (size_t)l * D * D, D, 64 * kb, 32 * nb, (bf16*)(a.ws + WS_BT2 + l * BT2_L), 2 * D, ((32 * nb) & ~255) + tile_perm((32 * nb) & 255), D, scr, F.lane);
        else transpose_item(a.w_out + (size_t)l * D * D, D, 64 * kb, 32 * nb, (bf16*)(a.ws + WS_BT3 + l * BT3_L), D, ((32 * nb) & ~255) + tile_perm((32 * nb) & 255), 0, scr, F.lane);
    }
    (void)ws16;
    { const int gt = F.vcu * NWAVES * 64 + F.wave * 64 + F.lane;
        if (gt < 16 * 2 * 192) { const int h = gt / 384, rem = gt % 384, sp = rem / 192, j = rem % 192, dist = 159 - (j + sp);
            const float v = (dist >= 0 && dist < 128) ? a.rel_bias[t5_bucket(dist) * NH + h] * LOG2E : -1e30f;
            *(float*)(a.ws + WS_TY + h * 1792 + sp * 896 + j * 4) = v; } }
    { bf16* Wt = (bf16*)(a.ws + WS_WT);
        const int gt = F.vcu * NWAVES * 64 + F.wave * 64 + F.lane, NT = F.G * NWAVES * 64;
        for (int it = gt; it < DEPTH * 8 * 128 * 16; it += NT) { const int s8 = (it & 15) * 8, tt = (it >> 4) & 127; const float* src = a.w_sp + (size_t)(it >> 4) * 128 + s8;
            const f32x4 w0 = *(const f32x4*)src, w1 = *(const f32x4*)(src + 4); v4u o;
            o.x = pk2(s8 + 0 <= tt ? w0.x : 0.f, s8 + 1 <= tt ? w0.y : 0.f); o.y = pk2(s8 + 2 <= tt ? w0.z : 0.f, s8 + 3 <= tt ? w0.w : 0.f);
            o.z = pk2(s8 + 4 <= tt ? w1.x : 0.f, s8 + 5 <= tt ? w1.y : 0.f); o.w = pk2(s8 + 6 <= tt ? w1.z : 0.f, s8 + 7 <= tt ? w1.w : 0.f);
            *(v4u*)(Wt + (size_t)(it >> 4) * 128 + s8) = o; } }
    bf16* H = (bf16*)(a.ws + WS_H);
    for (int m = gw * 4; m < M; m += NGW * 4) {
        f32x4 v[4][4];
#pragma unroll
        for (int r = 0; r < 4; ++r) { const GAS f32x4* xr = (const GAS f32x4*)(a.x + (size_t)(m + r) * D) + F.lane;
#pragma unroll
            for (int j = 0; j < 4; ++j) v[r][j] = __builtin_nontemporal_load(xr + 64 * j); }
        float rs4[4];
#pragma unroll
        for (int r = 0; r < 4; ++r) rs4[r] = rms_row_to_bf16(v[r], a.pre_norm, H, m + r, F.lane);
        if (F.lane < 4) ((float*)(a.ws + WS_RS))[m + F.lane] = F.lane == 0 ? rs4[0] : F.lane == 1 ? rs4[1] : F.lane == 2 ? rs4[2] : rs4[3];
    }
}

namespace mix {
typedef short bf16x8 __attribute__((ext_vector_type(8)));
typedef short s16x4 __attribute__((ext_vector_type(4)));
typedef float f32x16 __attribute__((ext_vector_type(16)));
typedef float f32x2 __attribute__((ext_vector_type(2)));
constexpr float NEG = -1e30f;
constexpr int L_K = 0, L_V = 32768, L_OST = 65536, L_BIAS = RING_BYTES + 1024, L_STAT = L_BIAS + 28672;
static_assert(L_STAT + 1024 <= LDS_BYTES, "mixer LDS map");
constexpr int BIAS_H = 1792, BIAS_S = 896;
__device__ __forceinline__ int crow(int r, int hi) { return (r & 3) + 8 * (r >> 2) + 4 * hi; }
__device__ __forceinline__ unsigned cvtpk(float lo, float hi) { typedef __bf16 bf2 __attribute__((ext_vector_type(2))); f32x2 v = {lo, hi}; bf2 b = __builtin_convertvector(v, bf2); return __builtin_bit_cast(unsigned, b); }
__device__ __forceinline__ s16x4 vtr(const LAS unsigned char* p) { typedef short v4i16_t __attribute__((ext_vector_type(4))); return __builtin_bit_cast(s16x4, __builtin_amdgcn_ds_read_tr16_b64_v4i16((LAS v4i16_t*)p)); }
__device__ __forceinline__ float xhalf_max(float m) { auto rr = __builtin_amdgcn_permlane32_swap(__float_as_uint(m), __float_as_uint(m), false, false); return fmaxf(__uint_as_float(rr[0]), __uint_as_float(rr[1])); }
__device__ __forceinline__ float xhalf_sum(float m) { auto rr = __builtin_amdgcn_permlane32_swap(__float_as_uint(m), __float_as_uint(m), false, false); return __uint_as_float(rr[0]) + __uint_as_float(rr[1]); }

__device__ __forceinline__ void attn_item(LAS unsigned char* lds, bf16* Qc, const bf16* Gc, bool first, int h, int qi, float sink2, int lane_, int wave, bf16x8 (&qf)[4], bool pre) {
    int lane = lane_; asm volatile("" : "+v"(lane));
    const int q = lane & 31, hi = lane >> 5;
    bf16x8 qn[4];
    if (pre) { const bf16* qrow = Qc + (32 * (qi + 1) + q) * PROW + 8 * hi;
#pragma unroll
        for (int d0 = 0; d0 < 4; ++d0) qn[d0] = *(const bf16x8*)(qrow + 16 * d0); }
    else {
#pragma unroll
        for (int d0 = 0; d0 < 4; ++d0) qn[d0] = qf[d0]; }
    v4u gl[4];
#pragma unroll
    for (int i = 0; i < 4; ++i) gl[i] = *(const v4u*)(Gc + (32 * qi + i * 8 + (lane >> 3)) * PROW + (lane & 7) * 8);
    const int spar = (q + 1) & 1;
    const LAS unsigned char* tb = lds + L_BIAS + h * BIAS_H + spar * BIAS_S + (31 - q + 4 * hi - spar) * 4;
    const int sw = (q >> 1) & 7;
    int kaddr[4];
#pragma unroll
    for (int d0 = 0; d0 < 4; ++d0) kaddr[d0] = L_K + q * 128 + ((((2 * d0) | hi) ^ sw) << 4);
    f32x16 p[5];
#pragma unroll
    for (int dl = 0; dl < 5; ++dl) {
        const int kb = qi + dl;
#pragma unroll
        for (int g4 = 0; g4 < 4; ++g4) { const f32x2 b0 = *(const LAS f32x2*)(tb + (32 * dl + 8 * g4) * 4), b1 = *(const LAS f32x2*)(tb + (32 * dl + 8 * g4 + 2) * 4);
            p[dl][4 * g4 + 0] = b0.x; p[dl][4 * g4 + 1] = b0.y; p[dl][4 * g4 + 2] = b1.x; p[dl][4 * g4 + 3] = b1.y; }
#pragma unroll
        for (int d0 = 0; d0 < 4; ++d0) { const bf16x8 kf = *(const LAS bf16x8*)(lds + kaddr[d0] + kb * 4096); p[dl] = __builtin_amdgcn_mfma_f32_32x32x16_bf16(kf, qf[d0], p[dl], 0, 0, 0); }
        if (first && kb < 4) {
#pragma unroll
            for (int r = 0; r < 16; ++r) p[dl][r] = NEG; }
    }
    float mx = sink2;
#pragma unroll
    for (int dl = 0; dl < 5; ++dl)
#pragma unroll
        for (int r = 0; r < 16; ++r) mx = fmaxf(mx, p[dl][r]);
    mx = xhalf_max(mx);
    float ls = 0.f;
#pragma unroll
    for (int dl = 0; dl < 5; ++dl)
#pragma unroll
        for (int r = 0; r < 16; ++r) { p[dl][r] = __builtin_amdgcn_exp2f(p[dl][r] - mx); ls += p[dl][r]; }
    ls = xhalf_sum(ls) + __builtin_amdgcn_exp2f(sink2 - mx);
    const float inv = __builtin_amdgcn_rcpf(ls);
    f32x16 o[2]; o[0] = f32x16{}; o[1] = f32x16{};
    const LAS unsigned char* vb = lds + L_V + (4 * hi + ((lane & 15) >> 2)) * 64 + ((lane >> 4) & 1) * 32 + (lane & 3) * 8;
#pragma unroll
    for (int dl = 0; dl < 5; ++dl) {
        const int kb = qi + dl;
#pragma unroll
        for (int s = 0; s < 2; ++s) {
            union { unsigned u[4]; bf16x8 v; } pa;
#pragma unroll
            for (int i = 0; i < 4; ++i) pa.u[i] = cvtpk(p[dl][8 * s + 2 * i] * inv, p[dl][8 * s + 2 * i + 1] * inv);
#pragma unroll
            for (int db = 0; db < 2; ++db) { const LAS unsigned char* vp = vb + db * 16384 + (32 * kb + 16 * s) * 64;
                const s16x4 lo = vtr(vp), hh = vtr(vp + 512);
                const bf16x8 vf = (bf16x8){lo[0], lo[1], lo[2], lo[3], hh[0], hh[1], hh[2], hh[3]};
                o[db] = __builtin_amdgcn_mfma_f32_32x32x16_bf16(pa.v, vf, o[db], 0, 0, 0); }
        }
    }
    LAS bf16* stg = (LAS bf16*)(lds + L_OST + wave * 8192);
#pragma unroll
    for (int r = 0; r < 16; ++r) { const int orow = crow(r, hi);
#pragma unroll
        for (int db = 0; db < 2; ++db) stg[orow * 64 + db * 32 + q] = (bf16)cvtpk(o[db][r], o[db][r]); }
#pragma unroll
    for (int i = 0; i < 4; ++i) { const int row = i * 8 + (lane >> 3), ch = lane & 7;
        const v4u ov = *(const LAS v4u*)(stg + row * 64 + ch * 8);
        bf16* gp = Qc + (32 * qi + row) * PROW + ch * 8;
        const v4u gv = gl[i]; v4u w;
        w.x = cvtpk(bflo(ov.x) * bflo(gv.x), bfhi(ov.x) * bfhi(gv.x)); w.y = cvtpk(bflo(ov.y) * bflo(gv.y), bfhi(ov.y) * bfhi(gv.y));
        w.z = cvtpk(bflo(ov.z) * bflo(gv.z), bfhi(ov.z) * bfhi(gv.z)); w.w = cvtpk(bflo(ov.w) * bflo(gv.w), bfhi(ov.w) * bfhi(gv.w));
        *(v4u*)gp = w; }
#pragma unroll
    for (int d0 = 0; d0 < 4; ++d0) qf[d0] = qn[d0];
}

struct SguPre { v4u gv[8]; };
__device__ __forceinline__ void sgu_prefetch(SguPre& p, const bf16* Pt, int g, int cb, int lane) {
    const bf16* Vc = Pt + poff(0, PC_VB + g * 128 + cb * 32);
#pragma unroll
    for (int i = 0; i < 8; ++i) { const int idx = i * 64 + lane, s = idx >> 2, ch = idx & 3; p.gv[i] = *(const v4u*)(Vc + s * PROW + ch * 8); }
}
__device__ __forceinline__ void sgu_colblock(LAS unsigned char* slab, const LAS float* statL, bf16* Pt, int g, int cb, const bf16* Wt, const LAS float* lnp, const float* bsp, int lane_,
                                             SguPre& cur, bool pre, int gn, int cbn) {
    int lane = lane_; asm volatile("" : "+v"(lane));
    const int q = lane & 31, hi = lane >> 5;
    bf16* Uc = Pt + poff(0, PC_UG + g * 128 + cb * 32);
    v4u ugr[8];
#pragma unroll
    for (int i = 0; i < 8; ++i) { const int idx = i * 64 + lane, t = idx >> 2, ch = idx & 3; ugr[i] = *(const v4u*)(Uc + t * PROW + ch * 8); }
    const LAS float* lp = lnp + (lane & 3) * 8;
    const f32x4 g0 = *(const LAS f32x4*)lp, g1 = *(const LAS f32x4*)(lp + 4), b0 = *(const LAS f32x4*)(lp + 32), b1 = *(const LAS f32x4*)(lp + 36);
    const bf16* wrow = Wt + ((size_t)(g * 128 + q) * 128 + 8 * hi);
    bf16x8 a0[2], a3[8];
#pragma unroll
    for (int ks = 0; ks < 2; ++ks) a0[ks] = *(const bf16x8*)(wrow + 16 * ks);
#pragma unroll
    for (int ks = 0; ks < 8; ++ks) a3[ks] = *(const bf16x8*)(wrow + (size_t)96 * 128 + 16 * ks);
#pragma unroll
    for (int i = 0; i < 8; ++i) { const int idx = i * 64 + lane, s = idx >> 2, ch = idx & 3; const float mu = statL[s], rs = statL[128 + s]; const v4u w = cur.gv[i]; v4u o;
        o.x = cvtpk((bflo(w.x) - mu) * rs * g0.x + b0.x, (bfhi(w.x) - mu) * rs * g0.y + b0.y); o.y = cvtpk((bflo(w.y) - mu) * rs * g0.z + b0.z, (bfhi(w.y) - mu) * rs * g0.w + b0.w);
        o.z = cvtpk((bflo(w.z) - mu) * rs * g1.x + b1.x, (bfhi(w.z) - mu) * rs * g1.y + b1.y); o.w = cvtpk((bflo(w.w) - mu) * rs * g1.z + b1.z, (bfhi(w.w) - mu) * rs * g1.w + b1.w);
        *(LAS v4u*)(slab + s * 64 + ch * 16) = o; }
    if (pre) sgu_prefetch(cur, Pt, gn, cbn, lane);
    f32x16 acc[4];
#pragma unroll
    for (int tb = 0; tb < 4; ++tb) acc[tb] = f32x16{};
    const LAS unsigned char* vb = slab + (8 * hi + ((lane & 15) >> 2)) * 64 + ((lane >> 4) & 1) * 32 + (lane & 3) * 8;
#pragma unroll
    for (int ks = 0; ks < 8; ++ks) { const s16x4 lo = vtr(vb + (16 * ks) * 64), hh = vtr(vb + (16 * ks + 4) * 64);
        const bf16x8 bfr = (bf16x8){lo[0], lo[1], lo[2], lo[3], hh[0], hh[1], hh[2], hh[3]};
        if (ks < 2) acc[0] = __builtin_amdgcn_mfma_f32_32x32x16_bf16(a0[ks < 2 ? ks : 0], bfr, acc[0], 0, 0, 0);
        acc[3] = __builtin_amdgcn_mfma_f32_32x32x16_bf16(a3[ks], bfr, acc[3], 0, 0, 0); }
    asm volatile("" ::: "memory");
    bf16x8 a1[4], a2[6];
#pragma unroll
    for (int ks = 0; ks < 4; ++ks) a1[ks] = *(const bf16x8*)(wrow + (size_t)32 * 128 + 16 * ks);
#pragma unroll
    for (int ks = 0; ks < 6; ++ks) a2[ks] = *(const bf16x8*)(wrow + (size_t)64 * 128 + 16 * ks);
#pragma unroll
    for (int ks = 0; ks < 6; ++ks) { const s16x4 lo = vtr(vb + (16 * ks) * 64), hh = vtr(vb + (16 * ks + 4) * 64);
        const bf16x8 bfr = (bf16x8){lo[0], lo[1], lo[2], lo[3], hh[0], hh[1], hh[2], hh[3]};
        if (ks < 4) acc[1] = __builtin_amdgcn_mfma_f32_32x32x16_bf16(a1[ks < 4 ? ks : 0], bfr, acc[1], 0, 0, 0);
        acc[2] = __builtin_amdgcn_mfma_f32_32x32x16_bf16(a2[ks], bfr, acc[2], 0, 0, 0); }
    LAS bf16* sl16 = (LAS bf16*)slab;
#pragma unroll
    for (int tb = 0; tb < 4; ++tb)
#pragma unroll
        for (int r = 0; r < 16; ++r) { const int t = 32 * tb + crow(r, hi); const float v = acc[tb][r] + bsp[t]; sl16[t * 32 + q] = (bf16)cvtpk(v, v); }
#pragma unroll
    for (int i = 0; i < 8; ++i) { const int idx = i * 64 + lane, t = idx >> 2, ch = idx & 3;
        const v4u mv = *(const LAS v4u*)(slab + t * 64 + ch * 16);
        bf16* up = Uc + t * PROW + ch * 8; const v4u uv = ugr[i]; v4u w;
        w.x = cvtpk(bflo(mv.x) * bflo(uv.x), bfhi(mv.x) * bfhi(uv.x)); w.y = cvtpk(bflo(mv.y) * bflo(uv.y), bfhi(mv.y) * bfhi(uv.y));
        w.z = cvtpk(bflo(mv.z) * bflo(uv.z), bfhi(mv.z) * bfhi(uv.z)); w.w = cvtpk(bflo(mv.w) * bflo(uv.w), bfhi(mv.w) * bfhi(uv.w));
        *(v4u*)up = w; }
}
}

__device__ __forceinline__ void p2_mix_mfma(const Frame& F0, const Args& a, int l, unsigned* kvf, unsigned* kvw) {
    const Frame F = reframe(F0);
    bf16* P = (bf16*)(a.ws + WS_P);
    LAS unsigned char* lds = F.lds;
    LAS float* statL = (LAS float*)(lds + mix::L_STAT);
    const int tid = F.tid, lane = F.lane, wave = F.wave;
    const bf16* Wt = (const bf16*)(a.ws + WS_WT) + (size_t)l * 8 * 128 * 128;
    for (int t = F.vcu; t < M / 128; t += F.G) {
        const int tok0 = t * 128; const bool first = (t & 63) == 0;
        if (tid < 128) { const float* sp = (const float*)(a.ws + WS_ST) + ((size_t)l * M + tok0 + tid) * 2; const float s1 = sp[0], s2 = sp[1];
            const float mu = s1 * (1.f / D), var = fmaxf(s2 * (1.f / D) - mu * mu, 0.f); statL[tid] = mu; statL[128 + tid] = 1.0f / sqrtf(var + EPS); }
        v4u kvr[4], vvr[4];
#define KV_FETCH(hk_, R, COL) do { _Pragma("unroll") for (int i = 0; i < 4; ++i) { const int idx = tid + 512 * i, j = idx >> 3, ch = idx & 7; R[i] = (v4u){0u, 0u, 0u, 0u}; \
            if (!first || j >= 128) R[i] = *(const v4u*)(P + poff(tok0 - 128 + (j & 128), (COL) + (hk_) * 64) + (j & 127) * PROW + ch * 8); } } while (0)
        if (kvf != nullptr && (t & 63) == 32) {
            if (tid == 0) { unsigned* fw = kvf + 64 * (t >> 6); unsigned sp_ = 0;
                while (__hip_atomic_load(fw, __ATOMIC_RELAXED, __HIP_MEMORY_SCOPE_AGENT) < 8u) { __builtin_amdgcn_s_sleep(1); if (++sp_ > (1u << 22)) break; }
                __builtin_amdgcn_fence(__ATOMIC_ACQUIRE, "agent"); asm volatile("s_waitcnt vmcnt(0)" ::: "memory"); }
            __syncthreads(); }
        KV_FETCH(0, kvr, PC_K); KV_FETCH(0, vvr, PC_V);
        if (t == F.vcu) {
        for (int c = tid; c < 28672 / 16; c += 512) *(LAS v4u*)(lds + mix::L_BIAS + c * 16) = *(const v4u*)(a.ws + WS_TY + c * 16);
        }
        for (int hk = 0; hk < NKV; ++hk) {
            const int h = hk * 8 + wave; const float sink2 = a.sinks[l * NH + h] * LOG2E;
            mix::bf16x8 qf[4];
            bf16* Qc = P + poff(tok0, PC_Q + h * 64); const bf16* Gc = P + poff(tok0, PC_GA + h * 64);
            { const bf16* qrow = Qc + (lane & 31) * PROW + 8 * (lane >> 5);
#pragma unroll
                for (int d0 = 0; d0 < 4; ++d0) qf[d0] = *(const mix::bf16x8*)(qrow + 16 * d0); }
            __syncthreads();
#pragma unroll
            for (int i = 0; i < 4; ++i) { const int idx = tid + 512 * i, j = idx >> 3, ch = idx & 7;
                *(LAS v4u*)(lds + mix::L_K + j * 128 + ((ch ^ ((j >> 1) & 7)) << 4)) = kvr[i];
                *(LAS v4u*)(lds + mix::L_V + (ch >> 2) * 16384 + j * 64 + (ch & 3) * 16) = vvr[i]; }
            __syncthreads();
            if (kvw != nullptr && (t & 63) == 32 && hk == NKV - 1 && tid == 0) __hip_atomic_store(kvw + 64 * (t >> 6), 1u, __ATOMIC_RELAXED, __HIP_MEMORY_SCOPE_AGENT);
#pragma unroll 1
            for (int qi = 0; qi < 3; ++qi) mix::attn_item(lds, Qc, Gc, first, h, qi, sink2, lane, wave, qf, true);
            if (hk + 1 < NKV) { KV_FETCH(hk + 1, kvr, PC_K); KV_FETCH(hk + 1, vvr, PC_V); }
            mix::attn_item(lds, Qc, Gc, first, h, 3, sink2, lane, wave, qf, false);
        }
#undef KV_FETCH
        mix::SguPre spre; mix::sgu_prefetch(spre, P + poff(tok0, 0), wave >> 2, wave & 3, lane);
        LAS float* lnp = (LAS float*)(lds + mix::L_BIAS + wave * 1024);
        { const int bi = lane >> 4, which = (lane >> 3) & 1, chn = lane & 7; const float* src = (which ? a.ln_b : a.ln_g) + l * D + (2 * bi + (wave >> 2)) * 128 + (wave & 3) * 32 + chn * 4;
          *(LAS f32x4*)(lnp + bi * 64 + which * 32 + chn * 4) = *(const f32x4*)src; }
#pragma unroll 1
        for (int i = 0; i < 4; ++i) { const int g = 2 * i + (wave >> 2), cb = wave & 3;
            mix::sgu_colblock(lds + mix::L_OST + wave * 8192, statL, P + poff(tok0, 0), g, cb, Wt, lnp + i * 64, a.b_sp + ((size_t)l * 8 + g) * 128, lane, spre, i < 3, g + 2, cb); }
        __syncthreads();
    }
}

template <size_t BYTES> __device__ __forceinline__ void warm_image(const unsigned char* img, int bx, int wave) {
    constexpr int NV = (int)(BYTES / 16 / GRID); static_assert(NV <= 8 * NWAVES * 64, "warm_image: at most eight touches per thread");
    int tz = lane_id_fresh() + 64 * wave; asm volatile("" : "+v"(tz));
    const unsigned* src = (const unsigned*)img + (size_t)bx * NV * 4 + 4 * tz; unsigned tq[8];
#pragma unroll
    for (int k = 0; k < 8; ++k) tq[k] = (k * NWAVES * 64 < NV && tz + k * NWAVES * 64 < NV) ? src[(size_t)k * NWAVES * 64 * 4] : 0u;
    asm volatile("" :: "v"(tq[0] ^ tq[1] ^ tq[2] ^ tq[3] ^ tq[4] ^ tq[5] ^ tq[6] ^ tq[7]));
}

__global__ void __launch_bounds__(NWAVES * 64, 2) fwd_kernel(Args args) {
    extern __shared__ __attribute__((aligned(16))) unsigned char lds_raw[];
    Frame F;
    F.lds = (LAS unsigned char*)lds_raw;
    F.tid = threadIdx.x; F.lane = F.tid & 63; F.wave = __builtin_amdgcn_readfirstlane(F.tid >> 6);
    F.G = GRID; { const int bx = blockIdx.x; F.vcu = (bx % 8) * (GRID / 8) + bx / 8; }
    unsigned* ctl = (unsigned*)(args.ws + WS_CTL);
    for (int u = F.tid; u < (LDS_BYTES - LDSCTL_OFF) / 4; u += NWAVES * 64) ((LAS unsigned*)(F.lds + LDSCTL_OFF))[u] = 0u;
    __syncthreads();
    XcdBarrier bar = xcd_barrier_post(ctl + CW_BAR, (volatile LAS unsigned*)(F.lds + MISC_OFF) + 8);
    const int lo = args.ph_lo, hi = args.ph_hi;
    int ph = 0;
#define PHASE_BEGIN if (lo <= ph && ph < hi) {
#define PHASE_END   if (ph + 1 < hi) xcd_barrier(bar, F.wave); } ++ph;
#define PHASE_END_C(c) if ((c) && ph + 1 < hi) xcd_barrier(bar, F.wave); } ++ph;
#define PHASE_END_LC(c) if ((c) && ph + 1 < hi) { if (loc) xcd_barrier_local(bar, F.wave); else xcd_barrier(bar, F.wave); } } ++ph;
#define PHASE_END_L if (ph + 1 < hi) { if (loc) xcd_barrier_local(bar, F.wave); else xcd_barrier(bar, F.wave); } } ++ph;

    PHASE_BEGIN p0_prologue(F, args); PHASE_END
    int bxp = blockIdx.x; bool loc = false;
    { volatile LAS unsigned* st = (volatile LAS unsigned*)(F.lds + MISC_OFF) + 8; const unsigned even = st[2], rank = st[3];
      if (even && rank < (unsigned)(GRID / 8) && bar.x < 8u) { bxp = (int)(rank * 8u + bar.x); loc = true; } }
    bxp = __builtin_amdgcn_readfirstlane(bxp);
    F.vcu = (bxp % 8) * (GRID / 8) + bxp / 8;
    bf16* H = (bf16*)(args.ws + WS_H); bf16* P = (bf16*)(args.ws + WS_P);
    for (int l = 0; l < DEPTH; ++l) {
        int bx = bxp; asm volatile("" : "+s"(bx));
        PHASE_BEGIN
            pg8::Gemm g{H, (const bf16*)(args.ws + WS_BT1 + l * BT1_L), M, INC, D, HW_BLOCKED ? 64 : D, HW_BLOCKED ? 64 : D, HW_BLOCKED ? (size_t)16384 : (size_t)128, HW_BLOCKED ? (size_t)(D / 64) * 16384 : (size_t)128 * D * 2, HW_BLOCKED ? (size_t)16384 : (size_t)128, HW_BLOCKED ? (size_t)(D / 64) * 16384 : (size_t)128 * D * 2}; pg8::StaticOrderSplit S; S.init(M, INC, F.G, bx);
            unsigned* kvf = loc ? ctl + CW_KVF + l * 4 * 64 : nullptr;
            pg8::Epi1 E{P, (float*)(args.ws + WS_ST) + (size_t)l * M * 2, kvf, (PG8_LAS unsigned*)(F.lds + MISC_OFF) + 16, (loc && l > 0) ? ctl + CW_KVW + (l - 1) * 4 * 64 : nullptr};
            pg8::gemm_phase<pg8::Epi1, pg8::StaticOrderSplit, true>(F.lds + RING_OFF, g, S, E, F.wave);
        PHASE_END_L
        PHASE_BEGIN
            p2_mix_mfma(F, args, l, loc ? ctl + CW_KVF + l * 4 * 64 : nullptr, (loc && l + 1 < DEPTH) ? ctl + CW_KVW + l * 4 * 64 : nullptr);
            warm_image<BT2_L>(args.ws + WS_BT2 + (size_t)l * BT2_L, bx, F.wave);
        PHASE_END_L
        PHASE_BEGIN
            pg8::Gemm g{P + poff(0, PC_Q), (const bf16*)(args.ws + WS_BT2 + l * BT2_L), M, D, 2 * D, PROJ_BLOCKED ? 64 : PP, HW_BLOCKED ? 64 : 2 * D, PROJ_BLOCKED ? (size_t)16384 : (size_t)128, PROJ_BLOCKED ? (size_t)(PP / 64) * 16384 : (size_t)128 * PP * 2, HW_BLOCKED ? (size_t)16384 : (size_t)128, HW_BLOCKED ? (size_t)(2 * D / 64) * 16384 : (size_t)128 * 2 * D * 2}; pg8::StaticOrder S; S.init(M, D, F.G, bx);
            pg8::Epi2 E{P};
            pg8::gemm_phase<pg8::Epi2, pg8::StaticOrder, true>(F.lds + RING_OFF, g, S, E, F.wave);
            warm_image<BT3_L>(args.ws + WS_BT3 + (size_t)l * BT3_L, bx, F.wave);
            if (l + 1 < DEPTH) warm_image<BT1_L>(args.ws + WS_BT1 + (size_t)(l + 1) * BT1_L, bx, F.wave);
        PHASE_END_L
        PHASE_BEGIN
            pg8::Gemm g{P + poff(0, PC_GA), (const bf16*)(args.ws + WS_BT3 + l * BT3_L), M, D, D, PROJ_BLOCKED ? 64 : PP, HW_BLOCKED ? 64 : D, PROJ_BLOCKED ? (size_t)16384 : (size_t)128, PROJ_BLOCKED ? (size_t)(PP / 64) * 16384 : (size_t)128 * PP * 2, HW_BLOCKED ? (size_t)16384 : (size_t)128, HW_BLOCKED ? (size_t)(D / 64) * 16384 : (size_t)128 * D * 2}; pg8::StaticOrder S; S.init(M, D, F.G, bx);
            {
                float* RS = (float*)(args.ws + WS_RS);
                pg8::PanelRms st{(unsigned long long*)(args.ws + WS_XS + l * XS_BYTES), ctl + CW_SEAM + l * SEAM_BANK, RS + (size_t)l * M, (l + 1 < DEPTH) ? RS + (size_t)(l + 1) * M : nullptr};
                pg8::EpiNorm E{H, RS + (size_t)l * M, args.pre_norm + l * D, (l + 1 < DEPTH) ? nullptr : args.out, args.post_norm + l * D, args.pre_norm + (l + 1 < DEPTH ? l + 1 : 0) * D, (l + 1 < DEPTH) ? H : nullptr, st, F.lds + XTRA_OFF};
                pg8::gemm_phase<pg8::EpiNorm, pg8::StaticOrder, true>(F.lds + RING_OFF, g, S, E, F.wave);
            }
        PHASE_END_LC(l + 1 < DEPTH)
        ++ph;
    }
}

extern "C" void kernel_launch(void* const* d_in, const int* in_sizes, int n_in, void* d_out, int out_size, void* d_ws, size_t ws_size, hipStream_t stream) {
    static int grid = 0;
    if (grid == 0) {
        if (n_in != 13 || in_sizes[0] != M * D || out_size != M * D || ws_size < WS_END) { fprintf(stderr, "kernel_launch: unexpected shapes (n_in %d, in0 %d, out %d, ws %zu); nothing launched\n", n_in, n_in > 0 ? in_sizes[0] : -1, out_size, ws_size); grid = -1; return; }
        int dev = 0, cus = 0, per_cu = 0;
        if (hipGetDevice(&dev) != hipSuccess || hipDeviceGetAttribute(&cus, hipDeviceAttributeMultiprocessorCount, dev) != hipSuccess) { grid = -1; return; }
        if (hipFuncSetAttribute((const void*)fwd_kernel, hipFuncAttributeMaxDynamicSharedMemorySize, LDS_BYTES) != hipSuccess) { fprintf(stderr, "kernel_launch: hipFuncSetAttribute failed\n"); grid = -1; return; }
        if (hipOccupancyMaxActiveBlocksPerMultiprocessor(&per_cu, (const void*)fwd_kernel, NWAVES * 64, LDS_BYTES) != hipSuccess || per_cu < 1) fprintf(stderr, "kernel_launch: occupancy query reports %d\n", per_cu);
        (void)hipGetLastError();
        if (cus < GRID) { fprintf(stderr, "kernel_launch: built for a device with >= %d CUs (one resident workgroup per CU); this one has %d; nothing launched\n", GRID, cus); grid = -1; return; }
        grid = GRID;
    }
    if (grid < 0) return;
    (void)hipMemsetAsync((char*)d_ws + WS_CTL, 0, CTL_ZERO_BYTES, stream);
    (void)hipMemsetAsync((char*)d_ws + WS_ST, 0, ST_BYTES, stream);
    Args a{};
    a.x = (const float*)d_in[0]; a.rel_bias = (const float*)d_in[1]; a.pre_norm = (const float*)d_in[2]; a.post_norm = (const float*)d_in[3]; a.w_in = (const float*)d_in[4];
    a.sinks = (const float*)d_in[5]; a.ln_g = (const float*)d_in[6]; a.ln_b = (const float*)d_in[7]; a.w_sp = (const float*)d_in[8]; a.b_sp = (const float*)d_in[9];
    a.w_a = (const float*)d_in[10]; a.w_b = (const float*)d_in[11]; a.w_out = (const float*)d_in[12];
    a.out = (float*)d_out; a.ws = (unsigned char*)d_ws; a.ph_lo = 0; a.ph_hi = 1 + 5 * DEPTH;
    hipLaunchKernelGGL(fwd_kernel, dim3(grid), dim3(NWAVES * 64), LDS_BYTES, stream, a);
}
```
